# Optimizing an MI355X kernel written in HIP

```python
import jax, jax.numpy as jnp
from jax import lax
import numpy as np

D_MODEL = 1024
BATCH = 4
SEQ = 4096
DEPTH = 1

D_LRU = D_MODEL // 2
D_CM = D_MODEL - D_LRU
D_MIX = D_LRU + D_CM
LRU_HEADS = 8
LRU_HEAD_DIM = D_LRU // LRU_HEADS
CM_GROUPS = 8
CONV_SHORT = 4
CONV_LONG = 31
LRU_C = 8.0
D_FF = ((8 * D_MODEL + 3 * 256 - 1) // (3 * 256)) * 256
D_IN = 2 * D_LRU + 2 * D_CM
EPS = 1e-6

kernel_name = "hymba_style_rglru_conformer_hybrid"


def rmsnorm(x, g):
    xf = x.astype(jnp.float32)
    y = xf * lax.rsqrt(jnp.mean(xf * xf, axis=-1, keepdims=True) + EPS)
    return (y * g.astype(jnp.float32)).astype(x.dtype)


def layernorm(x, g, b):
    xf = x.astype(jnp.float32)
    mu = jnp.mean(xf, axis=-1, keepdims=True)
    var = jnp.mean(jnp.square(xf - mu), axis=-1, keepdims=True)
    y = (xf - mu) * lax.rsqrt(var + EPS)
    return (y * g.astype(jnp.float32) + b.astype(jnp.float32)).astype(x.dtype)


def causal_depthwise_conv(x, w, b):
    k = w.shape[0]
    c = x.shape[-1]
    y = lax.conv_general_dilated(
        x, w[:, None, :].astype(x.dtype), window_strides=(1,), padding=[(k - 1, 0)],
        dimension_numbers=('NWC', 'WIO', 'NWC'), feature_group_count=c)
    return y + b.astype(x.dtype)


def _lru_combine(left, right):
    a_l, b_l = left
    a_r, b_r = right
    return a_l * a_r, a_r * b_l + b_r


def rg_lru(x, w_a, b_a, w_x, b_x, lam):
    bsz, s, _ = x.shape
    xh = x.reshape(bsz, s, LRU_HEADS, LRU_HEAD_DIM)
    r = jax.nn.sigmoid(jnp.einsum('bshi,hij->bshj', xh, w_a).reshape(bsz, s, D_LRU) + b_a)
    i = jax.nn.sigmoid(jnp.einsum('bshi,hij->bshj', xh, w_x).reshape(bsz, s, D_LRU) + b_x)
    log_a = -LRU_C * r.astype(jnp.float32) * jax.nn.softplus(-lam.astype(jnp.float32))
    a = jnp.exp(log_a)
    mult = jnp.sqrt(-jnp.expm1(2.0 * log_a))
    b_in = mult * (i * x).astype(jnp.float32)
    _, h = lax.associative_scan(_lru_combine, (a, b_in), axis=1)
    return h.astype(x.dtype)


def setup_inputs(seed: int = 0) -> dict:
    key = jax.random.key(seed)
    ks = jax.random.split(key, 24)
    f32 = jnp.float32

    def nrm(k, shape, fan_in, scale=1.0):
        return jax.random.normal(k, shape, f32) * (scale * fan_in ** -0.5)

    def gain(k, shape):
        return 1.0 + 0.05 * jax.random.normal(k, shape, f32)

    def bias(k, shape):
        return 0.02 * jax.random.normal(k, shape, f32)

    u = jax.random.uniform(ks[9], (DEPTH, D_LRU), f32, 0.9, 0.999)
    a0 = u ** (1.0 / LRU_C)
    lru_lambda = jnp.log(a0) - jnp.log1p(-a0)

    return {
        "x": jax.random.normal(ks[0], (BATCH, SEQ, D_MODEL), f32),
        "norm_mix": gain(ks[1], (DEPTH, D_MODEL)),
        "w_in": nrm(ks[2], (DEPTH, D_MODEL, D_IN), D_MODEL),
        "conv4_w": nrm(ks[3], (DEPTH, CONV_SHORT, D_LRU), CONV_SHORT),
        "conv4_b": bias(ks[4], (DEPTH, D_LRU)),
        "gate_a_w": nrm(ks[5], (DEPTH, LRU_HEADS, LRU_HEAD_DIM, LRU_HEAD_DIM), LRU_HEAD_DIM),
        "gate_a_b": bias(ks[6], (DEPTH, D_LRU)),
        "gate_x_w": nrm(ks[7], (DEPTH, LRU_HEADS, LRU_HEAD_DIM, LRU_HEAD_DIM), LRU_HEAD_DIM),
        "gate_x_b": bias(ks[8], (DEPTH, D_LRU)),
        "lru_lambda": lru_lambda,
        "dw31_w": nrm(ks[10], (DEPTH, CONV_LONG, D_CM), CONV_LONG),
        "dw31_b": bias(ks[11], (DEPTH, D_CM)),
        "cm_ln_g": gain(ks[12], (DEPTH, D_CM)),
        "cm_ln_b": bias(ks[13], (DEPTH, D_CM)),
        "out_norm_lru": gain(ks[14], (DEPTH, D_LRU)),
        "out_norm_cm": gain(ks[15], (DEPTH, D_CM)),
        "w_out": nrm(ks[16], (DEPTH, D_MIX, D_MODEL), D_MIX, 0.5),
        "norm_ffn": gain(ks[17], (DEPTH, D_MODEL)),
        "w_gate": nrm(ks[18], (DEPTH, D_MODEL, D_FF), D_MODEL),
        "w_up": nrm(ks[19], (DEPTH, D_MODEL, D_FF), D_MODEL),
        "w_down": nrm(ks[20], (DEPTH, D_FF, D_MODEL), D_FF, 0.5),
        "norm_final": gain(ks[21], (D_MODEL,)),
    }


def reference(x, norm_mix, w_in, conv4_w, conv4_b, gate_a_w, gate_a_b, gate_x_w, gate_x_b,
              lru_lambda, dw31_w, dw31_b, cm_ln_g, cm_ln_b, out_norm_lru, out_norm_cm,
              w_out, norm_ffn, w_gate, w_up, w_down, norm_final):
    for l in range(DEPTH):
        h = rmsnorm(x, norm_mix[l])
        proj = jnp.einsum('bsd,de->bse', h, w_in[l])
        x_lru = proj[..., :D_LRU]
        g_lru = proj[..., D_LRU:2 * D_LRU]
        v_cm = proj[..., 2 * D_LRU:2 * D_LRU + D_CM]
        g_cm = proj[..., 2 * D_LRU + D_CM:]

        c = causal_depthwise_conv(x_lru, conv4_w[l], conv4_b[l])
        y_lru = rg_lru(c, gate_a_w[l], gate_a_b[l], gate_x_w[l], gate_x_b[l], lru_lambda[l])
        y_lru = y_lru * jax.nn.gelu(g_lru)

        glu = v_cm * jax.nn.sigmoid(g_cm)
        d = causal_depthwise_conv(glu, dw31_w[l], dw31_b[l])
        y_cm = jax.nn.silu(layernorm(d, cm_ln_g[l], cm_ln_b[l]))

        y = jnp.concatenate([rmsnorm(y_lru, out_norm_lru[l]),
                             rmsnorm(y_cm, out_norm_cm[l])], axis=-1)
        x = x + jnp.einsum('bse,ed->bsd', y, w_out[l])

        h = rmsnorm(x, norm_ffn[l])
        f = jax.nn.silu(jnp.einsum('bsd,df->bsf', h, w_gate[l])) * jnp.einsum('bsd,df->bsf', h, w_up[l])
        x = x + jnp.einsum('bsf,fd->bsd', f, w_down[l])
    return rmsnorm(x, norm_final)
```

```cpp
#include <hip/hip_runtime.h>
#include <hip/hip_cooperative_groups.h>
#include <cstdio>
#include <cstdint>
namespace cg = cooperative_groups;
namespace pg8 {
#define PG8_LAS __attribute__((address_space(3)))
typedef unsigned short bf16_t;
typedef short bf16x8 __attribute__((ext_vector_type(8)));
typedef float f32x4 __attribute__((ext_vector_type(4)));
typedef unsigned u32x4 __attribute__((ext_vector_type(4)));
constexpr int BM = 256, BK = 64, HALF = 128, HTB = HALF * BK * 2  , STAGE_BYTES = 8 * HTB, NXCD = 8, WGM = 8;

__host__ __device__ __forceinline__ int lds_byte(int r, int c) { const int st = (r >> 4) * 2 + (c >> 5), rr = r & 15, cc = c & 31, ob = rr * 64 + cc * 2; return st * 1024 + (ob ^ (((ob >> 9) & 1) << 5)); }
__host__ __device__ __forceinline__ void stage_rc(int b, int& R, int& C) { const int st = b / 1024, sb = b % 1024, swz = sb ^ (((sb >> 9) & 1) << 5); R = (st >> 1) * 16 + swz / 64; C = (st & 1) * 32 + (swz % 64) / 2; }
__host__ __device__ __forceinline__ int perm32(int rho) { const int n = rho >> 4, i = rho & 15; return 8 * (i >> 2) + 4 * n + (i & 3); }

struct Unit { int pm, pn; };
struct Gemm { const bf16_t* A; const bf16_t* Bt; int M, N, K; };

struct StaticOrder {
    int nM, nN, nwg, G, c;
    __host__ __device__ void init(int M, int N, int G_, int c_) { nM = M / BM; nN = N / BM; nwg = nM * nN; G = G_; c = c_; }
    __host__ __device__ bool next(int i, Unit& u) const {
        const long L = (long)i * G + c; if (L >= nwg) return false;
        int wgid = (int)L; { const int q = nwg / NXCD, r = nwg % NXCD, xcd = wgid % NXCD, off = wgid / NXCD; wgid = (xcd < r ? xcd * (q + 1) : r * (q + 1) + (xcd - r) * q) + off; }
        const int nig = WGM * nN, gid = wgid / nig, fm = gid * WGM, gsz = (nM - fm) < WGM ? (nM - fm) : WGM;
        u.pm = fm + ((wgid % nig) % gsz); u.pn = (wgid % nig) / gsz; return true;
    }
    __device__ __forceinline__ void a_ready(const Unit&) const {}
    __device__ __forceinline__ void done(const Unit&) const {}
};

__device__ __forceinline__ unsigned cvt_pk_bf16(float lo, float hi) { unsigned r; asm volatile("v_cvt_pk_bf16_f32 %0, %1, %2" : "=v"(r) : "v"(lo), "v"(hi)); return r; }
typedef float f32x2 __attribute__((ext_vector_type(2)));
__device__ __forceinline__ float sigmoid_f(float x) { return __builtin_amdgcn_rcpf(1.0f + __expf(-x)); }
__device__ __forceinline__ float gelu_tanh_f(float x) { return x * sigmoid_f(1.5957691216057308f * (x + 0.044715f * x * x * x)); }
__device__ __forceinline__ u32x4 pack8(const f32x4 a, const f32x4 b) { u32x4 w; w.x = cvt_pk_bf16(a[0], a[1]); w.y = cvt_pk_bf16(a[2], a[3]); w.z = cvt_pk_bf16(b[0], b[1]); w.w = cvt_pk_bf16(b[2], b[3]); return w; }

struct EpiInProj {
    static constexpr bool PERM = true, AFTER_DRAIN = false;
    bf16_t *XL, *GG, *GLU;
    __device__ __forceinline__ void operator()(const f32x4 (&acc)[2][2][4][2], const Unit& u, int wr, int wc, int fr, int fq) const {
        const int row0 = u.pm * BM + wr * 64 + fr, cin = wc * 32 + 8 * fq;
        if (u.pn < 4) {
            bf16_t* base = (u.pn < 2 ? XL : GG) + (u.pn & 1) * 256 + cin; const bool act = u.pn >= 2;
#pragma unroll
            for (int ai = 0; ai < 2; ++ai)
#pragma unroll
                for (int m = 0; m < 4; ++m) { bf16_t* rowp = base + (size_t)(row0 + ai * HALF + m * 16) * 512;
#pragma unroll
                    for (int bj = 0; bj < 2; ++bj) { f32x4 v0 = acc[ai][bj][m][0], v1 = acc[ai][bj][m][1];
                        if (act) {
#pragma unroll
                            for (int e = 0; e < 4; ++e) { v0[e] = gelu_tanh_f(v0[e]); v1[e] = gelu_tanh_f(v1[e]); } }
                        *(u32x4*)(rowp + bj * HALF) = pack8(v0, v1); } }
        } else {
            bf16_t* base = GLU + (u.pn - 4) * 128 + cin;
#pragma unroll
            for (int ai = 0; ai < 2; ++ai)
#pragma unroll
                for (int m = 0; m < 4; ++m) { bf16_t* rowp = base + (size_t)(row0 + ai * HALF + m * 16) * 512; f32x4 v0, v1;
#pragma unroll
                    for (int e = 0; e < 4; ++e) { v0[e] = acc[ai][0][m][0][e] * sigmoid_f(acc[ai][1][m][0][e]); v1[e] = acc[ai][0][m][1][e] * sigmoid_f(acc[ai][1][m][1][e]); }
                    *(u32x4*)rowp = pack8(v0, v1); }
        }
    }
};
template <bool WRITE_XN> struct EpiResid {
    static constexpr bool PERM = true, AFTER_DRAIN = false;
    const float* X; float* OUT; bf16_t* XN; const float* gain; float* slots;
    __device__ __forceinline__ void operator()(const f32x4 (&acc)[2][2][4][2], const Unit& u, int wr, int wc, int fr, int fq) const {
        const int col0 = u.pn * BM + wc * 32 + 8 * fq;
        f32x4 gv[2][2];
        if (WRITE_XN) {
#pragma unroll
            for (int bj = 0; bj < 2; ++bj)
#pragma unroll
                for (int n = 0; n < 2; ++n) gv[bj][n] = *(const f32x4*)(gain + col0 + bj * HALF + 4 * n); }
#pragma unroll
        for (int ai = 0; ai < 2; ++ai)
#pragma unroll
            for (int m = 0; m < 4; ++m) { const int row = u.pm * BM + ai * HALF + wr * 64 + m * 16 + fr; const size_t off = (size_t)row * 1024 + col0; float ss = 0.f;
#pragma unroll
                for (int bj = 0; bj < 2; ++bj) {
                    const f32x4 x0 = *(const f32x4*)(X + off + bj * HALF), x1 = *(const f32x4*)(X + off + bj * HALF + 4);
                    const f32x4 v0 = x0 + acc[ai][bj][m][0], v1 = x1 + acc[ai][bj][m][1];
                    *(f32x4*)(OUT + off + bj * HALF) = v0; *(f32x4*)(OUT + off + bj * HALF + 4) = v1;
                    ss += (v0[0] * v0[0] + v0[1] * v0[1]) + (v0[2] * v0[2] + v0[3] * v0[3]) + (v1[0] * v1[0] + v1[1] * v1[1]) + (v1[2] * v1[2] + v1[3] * v1[3]);
                    if (WRITE_XN) *(u32x4*)(XN + off + bj * HALF) = pack8(v0 * gv[bj][0], v1 * gv[bj][1]); }
                ss += __shfl_xor(ss, 16); ss += __shfl_xor(ss, 32);
                if (fq == 0) slots[(size_t)row * 16 + u.pn * 4 + wc] = ss; }
    }
};
struct EpiSwiGLU {
    static constexpr bool PERM = true, AFTER_DRAIN = false;
    bf16_t* H; const float* slots; int ldh;
    __device__ __forceinline__ void operator()(const f32x4 (&acc)[2][2][4][2], const Unit& u, int wr, int wc, int fr, int fq) const {
        const int cin = u.pn * 128 + wc * 32 + 8 * fq;
#pragma unroll
        for (int ai = 0; ai < 2; ++ai)
#pragma unroll
            for (int m = 0; m < 4; ++m) { const int row = u.pm * BM + ai * HALF + wr * 64 + m * 16 + fr;
                const f32x4* sp = (const f32x4*)(slots + (size_t)row * 16); const f32x4 s0 = sp[0], s1 = sp[1], s2 = sp[2], s3 = sp[3];
                const float tot = ((s0[0] + s0[1]) + (s0[2] + s0[3])) + ((s1[0] + s1[1]) + (s1[2] + s1[3])) + ((s2[0] + s2[1]) + (s2[2] + s2[3])) + ((s3[0] + s3[1]) + (s3[2] + s3[3]));
                const float rstd = __builtin_amdgcn_rsqf(tot * (1.0f / 1024.0f) + 1e-6f);
                f32x4 v0, v1;
#pragma unroll
                for (int e = 0; e < 4; ++e) { const float g0 = acc[ai][0][m][0][e] * rstd, u0 = acc[ai][1][m][0][e] * rstd, g1 = acc[ai][0][m][1][e] * rstd, u1 = acc[ai][1][m][1][e] * rstd;
                    v0[e] = g0 * sigmoid_f(g0) * u0; v1[e] = g1 * sigmoid_f(g1) * u1; }
                *(u32x4*)(H + (size_t)row * ldh + cin) = pack8(v0, v1); }
    }
};

template <class Epi, class Sched, bool ALIGN_EPI = false, bool SP2 = false>
__device__ __forceinline__ void gemm_phase(PG8_LAS unsigned char* lds, const Gemm g, const Sched& S, const Epi& E) {
    const int tid = threadIdx.x, wid = __builtin_amdgcn_readfirstlane(tid >> 6), lane = tid & 63, wr = wid >> 2, wc = wid & 3, fr = lane & 15, fq = lane >> 4;
    const int K = g.K, nt = K / BK;
    unsigned voffA[2], voffB[2];
#pragma unroll
    for (int i = 0; i < 2; ++i) { int R, C; stage_rc(tid * 16 + i * 8192, R, C); const int Rb = Epi::PERM ? ((R & ~31) + perm32(R & 31)) : R;
        voffA[i] = (unsigned)(R * K + C) * 2u; voffB[i] = (unsigned)(Rb * K + C) * 2u; }
    const size_t kstep = (size_t)(BK * 2);
    const size_t hstep = (size_t)HALF * K * 2;
    const size_t tstep = 2 * hstep;
    const unsigned ldsw = (unsigned)wid * 1024u;
    const int aoff = lds_byte(wr * 64 + fr, fq * 8), boff = lds_byte(wc * 32 + fr, fq * 8);
#define PG8_SA(b, h) (((b) * 2 + (h)) * HTB)
#define PG8_SB(b, h) ((4 + (b) * 2 + (h)) * HTB)
#define PG8_STAGE(bufoff, gbase, voff) do { _Pragma("unroll") for (int _i = 0; _i < 2; ++_i) \
        __builtin_amdgcn_global_load_lds((const unsigned*)((const char*)(gbase) + (voff)[_i]), (PG8_LAS unsigned*)(lds + (bufoff) + ldsw + _i * 8192), 16, 0, 0); } while (0)
#define PG8_LDA(dst, b, h) do { _Pragma("unroll") for (int m = 0; m < 4; ++m) _Pragma("unroll") for (int k = 0; k < 2; ++k) dst[m][k] = *(const PG8_LAS bf16x8*)(lds + PG8_SA(b, h) + aoff + m * 2048 + k * 1024); } while (0)
#define PG8_LDB(dst, b, h) do { _Pragma("unroll") for (int n = 0; n < 2; ++n) _Pragma("unroll") for (int k = 0; k < 2; ++k) dst[n][k] = *(const PG8_LAS bf16x8*)(lds + PG8_SB(b, h) + boff + n * 2048 + k * 1024); } while (0)
#define PG8_MMA(ai, bj, At, Bt) do { __builtin_amdgcn_s_setprio(1); _Pragma("unroll") for (int m = 0; m < 4; ++m) _Pragma("unroll") for (int n = 0; n < 2; ++n) _Pragma("unroll") for (int k = 0; k < 2; ++k) \
        acc[ai][bj][m][n] = __builtin_amdgcn_mfma_f32_16x16x32_bf16(Bt[n][k], At[m][k], acc[ai][bj][m][n], 0, 0, 0); __builtin_amdgcn_s_setprio(0); } while (0)
#define PG8_WAIT_V(n) asm volatile("s_waitcnt vmcnt(" #n ")" ::: "memory")
#define PG8_WAIT_L(n) asm volatile("s_waitcnt lgkmcnt(" #n ")" ::: "memory")
#define PG8_BAR __builtin_amdgcn_s_barrier()
#define PG8_SCHED __builtin_amdgcn_sched_barrier(0)
    Unit cur, nxt; int ui = 0;
    if (!S.next(0, cur)) return;
    f32x4 acc[2][2][4][2];
#pragma unroll
    for (int a = 0; a < 2; ++a)
#pragma unroll
        for (int b = 0; b < 2; ++b)
#pragma unroll
            for (int m = 0; m < 4; ++m)
#pragma unroll
                for (int n = 0; n < 2; ++n) acc[a][b][m][n] = (f32x4){0.f, 0.f, 0.f, 0.f};
    bf16x8 At[4][2], B0[2][2], B1[2][2];
    const char* cA = (const char*)g.A + (size_t)cur.pm * tstep; const char* cB = (const char*)g.Bt + (size_t)cur.pn * tstep;
    S.a_ready(cur);
    if constexpr (SP2) {
        PG8_STAGE(PG8_SB(0, 0), cB, voffB); PG8_STAGE(PG8_SB(0, 1), cB + hstep, voffB); PG8_STAGE(PG8_SA(0, 0), cA, voffA); PG8_STAGE(PG8_SA(0, 1), cA + hstep, voffA);
        if (wr == 1) PG8_BAR;
        PG8_WAIT_V(2); PG8_BAR;
        PG8_STAGE(PG8_SB(1, 0), cB + kstep, voffB); PG8_STAGE(PG8_SA(1, 0), cA + kstep, voffA); PG8_STAGE(PG8_SB(1, 1), cB + hstep + kstep, voffB);
        PG8_WAIT_V(6); PG8_BAR;
    } else {
        PG8_STAGE(PG8_SB(0, 0), cB, voffB); PG8_STAGE(PG8_SA(0, 0), cA, voffA); PG8_STAGE(PG8_SB(0, 1), cB + hstep, voffB); PG8_STAGE(PG8_SA(0, 1), cA + hstep, voffA);
        if (wr == 1) PG8_BAR;
        PG8_WAIT_V(4); PG8_BAR;
        PG8_STAGE(PG8_SB(1, 0), cB + kstep, voffB); PG8_STAGE(PG8_SA(1, 0), cA + kstep, voffA); PG8_STAGE(PG8_SB(1, 1), cB + hstep + kstep, voffB);
        PG8_WAIT_V(6); PG8_BAR;
    }
    for (;;) {
        const bool has_next = S.next(ui + 1, nxt);
        const char* nA = has_next ? (const char*)g.A + (size_t)nxt.pm * tstep : cA; const char* nB = has_next ? (const char*)g.Bt + (size_t)nxt.pn * tstep : cB;
        for (int t = 0; t < nt; t += 2) {
            const bool last = (t == nt - 2);
            const char* a1 = cA + (size_t)(t + 1) * kstep;
            const char* a2 = last ? nA : cA + (size_t)(t + 2) * kstep; const char* b2 = last ? nB : cB + (size_t)(t + 2) * kstep;
            const char* a3 = a2 + kstep; const char* b3 = b2 + kstep;
            if (last && has_next) S.a_ready(nxt);
            if constexpr (SP2) {
            PG8_LDB(B0, 0, 0); PG8_LDB(B1, 0, 1); PG8_SCHED; PG8_LDA(At, 0, 0); PG8_STAGE(PG8_SA(1, 1), a1 + hstep, voffA);
            PG8_WAIT_V(8); PG8_WAIT_L(0); PG8_BAR; PG8_MMA(0, 0, At, B0); PG8_MMA(0, 1, At, B1); PG8_BAR; PG8_SCHED;
            PG8_LDA(At, 0, 1); PG8_STAGE(PG8_SB(0, 0), b2, voffB); PG8_STAGE(PG8_SB(0, 1), b2 + hstep, voffB); PG8_STAGE(PG8_SA(0, 0), a2, voffA);
            PG8_WAIT_V(8); PG8_WAIT_L(0); PG8_BAR; PG8_MMA(1, 0, At, B0); PG8_MMA(1, 1, At, B1); PG8_BAR; PG8_SCHED;
            PG8_LDB(B0, 1, 0); PG8_LDB(B1, 1, 1); PG8_SCHED; PG8_LDA(At, 1, 0); PG8_STAGE(PG8_SA(0, 1), a2 + hstep, voffA);
            PG8_WAIT_V(8); PG8_WAIT_L(0); PG8_BAR; PG8_MMA(0, 0, At, B0); PG8_MMA(0, 1, At, B1); PG8_BAR; PG8_SCHED;
            PG8_LDA(At, 1, 1); PG8_STAGE(PG8_SB(1, 0), b3, voffB); PG8_STAGE(PG8_SB(1, 1), b3 + hstep, voffB); PG8_STAGE(PG8_SA(1, 0), a3, voffA);
            PG8_WAIT_V(8); PG8_WAIT_L(0); PG8_BAR; PG8_MMA(1, 0, At, B0); PG8_MMA(1, 1, At, B1); PG8_BAR; PG8_SCHED;
            } else {
            PG8_LDB(B0, 0, 0); PG8_SCHED; PG8_LDA(At, 0, 0); PG8_STAGE(PG8_SA(1, 1), a1 + hstep, voffA);
            PG8_WAIT_L(8); PG8_BAR; PG8_WAIT_L(0); PG8_MMA(0, 0, At, B0); PG8_BAR; PG8_SCHED;
            PG8_LDB(B1, 0, 1); PG8_STAGE(PG8_SB(0, 0), b2, voffB);
            PG8_BAR; PG8_WAIT_L(0); PG8_MMA(0, 1, At, B1); PG8_BAR;
            PG8_LDA(At, 0, 1); PG8_STAGE(PG8_SA(0, 0), a2, voffA);
            PG8_BAR; PG8_WAIT_L(0); PG8_MMA(1, 0, At, B0); PG8_BAR; PG8_SCHED;
            PG8_STAGE(PG8_SB(0, 1), b2 + hstep, voffB);
            PG8_WAIT_V(6); PG8_BAR; PG8_MMA(1, 1, At, B1); PG8_BAR;
            PG8_LDB(B0, 1, 0); PG8_SCHED; PG8_LDA(At, 1, 0); PG8_STAGE(PG8_SA(0, 1), a2 + hstep, voffA);
            PG8_WAIT_L(8); PG8_BAR; PG8_WAIT_L(0); PG8_MMA(0, 0, At, B0); PG8_BAR; PG8_SCHED;
            PG8_LDB(B1, 1, 1); PG8_STAGE(PG8_SB(1, 0), b3, voffB);
            PG8_BAR; PG8_WAIT_L(0); PG8_MMA(0, 1, At, B1); PG8_BAR;
            PG8_LDA(At, 1, 1); PG8_STAGE(PG8_SA(1, 0), a3, voffA);
            PG8_BAR; PG8_WAIT_L(0); PG8_MMA(1, 0, At, B0); PG8_BAR; PG8_SCHED;
            PG8_STAGE(PG8_SB(1, 1), b3 + hstep, voffB);
            PG8_WAIT_V(6); PG8_BAR; PG8_MMA(1, 1, At, B1); PG8_BAR;
            }
        }
        if constexpr (ALIGN_EPI) { if (wr == 0) PG8_BAR; }
        if constexpr (!Epi::AFTER_DRAIN) { E(acc, cur, wr, wc, fr, fq); S.done(cur); }
        if (!has_next) break;
#pragma unroll
        for (int a = 0; a < 2; ++a)
#pragma unroll
            for (int b = 0; b < 2; ++b)
#pragma unroll
                for (int m = 0; m < 4; ++m)
#pragma unroll
                    for (int n = 0; n < 2; ++n) acc[a][b][m][n] = (f32x4){0.f, 0.f, 0.f, 0.f};
        cur = nxt; cA = nA; cB = nB; ++ui;
        if constexpr (ALIGN_EPI) { if (wr == 1) PG8_BAR; }
    }
    PG8_WAIT_V(0);
    if constexpr (!ALIGN_EPI) { if (wr == 0) PG8_BAR; }
    PG8_BAR;
    if constexpr (Epi::AFTER_DRAIN) { E.fused(acc, cur, wr, wc, fr, fq, lds, wid, lane); S.done(cur); }
#undef PG8_SA
#undef PG8_SB
#undef PG8_STAGE
#undef PG8_LDA
#undef PG8_LDB
#undef PG8_MMA
#undef PG8_WAIT_V
#undef PG8_WAIT_L
#undef PG8_BAR
#undef PG8_SCHED
}
}

#ifndef MK_N_LAUNCHES
#define MK_N_LAUNCHES 1
#endif
constexpr int NWAVES = 8, NPHASE = 8;
constexpr int BATCH = 4, SEQ = 4096, D = 1024, DL = 512, DC = 512, DIN = 2048, FF = 2816, NGU = 2 * FF;
constexpr int M = BATCH * SEQ;
constexpr float EPS = 1e-6f;
constexpr int TC = 32, NCH = SEQ / TC, NTILE = M / TC;

constexpr size_t MiB = 1u << 20;
constexpr size_t WS_WIN = 2 * MiB, WS_WOUT = 6 * MiB, WS_WGU = 8 * MiB, WS_WD = 19 * MiB;
constexpr size_t WS_S1 = 25 * MiB, WS_S2 = 26 * MiB, WS_AGG = 27 * MiB;
constexpr size_t WS_XN = 32 * MiB;
constexpr size_t WS_XL = 64 * MiB, WS_GG = 80 * MiB, WS_GLU = 96 * MiB, WS_Y = 112 * MiB;
constexpr size_t WS_H = 64 * MiB, WS_END = 152 * MiB;
static_assert(WS_WD + (size_t)D * FF * 2 <= WS_S1 && WS_AGG + (size_t)BATCH * NCH * 512 * 8 <= WS_XN && WS_H + (size_t)M * FF * 2 <= WS_END, "d_ws map");

constexpr int RING_BYTES = 131072, LDS_BYTES = 147456;

#define GAS __attribute__((address_space(1)))
#define LAS __attribute__((address_space(3)))
typedef unsigned short bf16;
typedef unsigned v4u __attribute__((ext_vector_type(4)));
typedef unsigned v2u __attribute__((ext_vector_type(2)));
typedef float f32x4 __attribute__((ext_vector_type(4)));
typedef float f32x2 __attribute__((ext_vector_type(2)));
typedef short bf16x8 __attribute__((ext_vector_type(8)));
__device__ __forceinline__ unsigned f2bf(float f) { unsigned u = __builtin_bit_cast(unsigned, f); return (u + 0x7fffu + ((u >> 16) & 1u)) >> 16; }
__device__ __forceinline__ unsigned pk2(float lo, float hi) { return f2bf(lo) | (f2bf(hi) << 16); }
__device__ __forceinline__ float bflo(unsigned w) { return __uint_as_float(w << 16); }
__device__ __forceinline__ float bfhi(unsigned w) { return __uint_as_float(w & 0xffff0000u); }
__device__ __forceinline__ float sigm(float x) { return 1.0f / (1.0f + __expf(-x)); }
__device__ __forceinline__ float wave_sum(float v) {
#pragma unroll
    for (int o = 1; o < 64; o <<= 1) v += __shfl_xor(v, o);
    return v;
}

struct Frame {
    LAS unsigned char* lds; int tid, lane, wave, G, bx;
    const float* in[22]; float* out; unsigned char* ws;
};
struct Args { const float* in[22]; float* out; unsigned char* ws; int ph_lo, ph_hi; };

__device__ __forceinline__ void transpose_item(const float* W, int K, int N, bf16* WT, int k0, int n0, int drow0, LAS float* scr, int lane) {
#pragma unroll 8
    for (int i = 0; i < 32; ++i) { const int kk = 2 * i + (lane >> 5); scr[kk * 33 + (lane & 31)] = W[(size_t)(k0 + kk) * N + n0 + (lane & 31)]; }
    asm volatile("s_waitcnt lgkmcnt(0)" ::: "memory");
    const int c = lane & 7;
#pragma unroll
    for (int j = 0; j < 4; ++j) { const int n = (lane >> 3) + 8 * j; const LAS float* s = scr + (8 * c) * 33 + n;
        v4u o; o.x = pk2(s[0 * 33], s[1 * 33]); o.y = pk2(s[2 * 33], s[3 * 33]); o.z = pk2(s[4 * 33], s[5 * 33]); o.w = pk2(s[6 * 33], s[7 * 33]);
        *(v4u*)(WT + (size_t)(drow0 + n) * K + k0 + 8 * c) = o; }
    asm volatile("s_waitcnt lgkmcnt(0)" ::: "memory");
}
__device__ __forceinline__ int il128(int n, int half) { return 256 * (n >> 7) + 128 * half + (n & 127); }
__device__ __forceinline__ void p0_prologue(const Frame& F) {
    LAS float* scr = (LAS float*)(F.lds + F.wave * 16384);
    const int gw = F.bx * NWAVES + F.wave, NGW = F.G * NWAVES;
    constexpr int I_IN = (D / 64) * (DIN / 32), I_OUT = (D / 64) * (D / 32), I_G = (D / 64) * (FF / 32), I_D = (FF / 64) * (D / 32);
    constexpr int NITEMS = I_IN + I_OUT + 2 * I_G + I_D;
    bf16* Win_t = (bf16*)(F.ws + WS_WIN); bf16* Wout_t = (bf16*)(F.ws + WS_WOUT); bf16* Wgu_t = (bf16*)(F.ws + WS_WGU); bf16* Wd_t = (bf16*)(F.ws + WS_WD);
    for (int it = gw; it < NITEMS; it += NGW) {
        int r = it;
        if (r < I_IN) { const int nb = DIN / 32, k0 = 64 * (r / nb), n0 = 32 * (r % nb);
            const int dr = n0 < 1024 ? n0 : (n0 < 1536 ? 1024 + il128(n0 - 1024, 0) : 1024 + il128(n0 - 1536, 1));
            transpose_item(F.in[2], D, DIN, Win_t, k0, n0, dr, scr, F.lane); continue; } r -= I_IN;
        if (r < I_OUT) { const int nb = D / 32, k0 = 64 * (r / nb), n0 = 32 * (r % nb); transpose_item(F.in[16], D, D, Wout_t, k0, n0, n0, scr, F.lane); continue; } r -= I_OUT;
        if (r < I_G) { const int nb = FF / 32, k0 = 64 * (r / nb), n0 = 32 * (r % nb); transpose_item(F.in[18], D, FF, Wgu_t, k0, n0, il128(n0, 0), scr, F.lane); continue; } r -= I_G;
        if (r < I_G) { const int nb = FF / 32, k0 = 64 * (r / nb), n0 = 32 * (r % nb); transpose_item(F.in[19], D, FF, Wgu_t, k0, n0, il128(n0, 1), scr, F.lane); continue; } r -= I_G;
        { const int nb = D / 32, k0 = 64 * (r / nb), n0 = 32 * (r % nb); transpose_item(F.in[20], FF, D, Wd_t, k0, n0, n0, scr, F.lane); }
    }
    bf16* XN = (bf16*)(F.ws + WS_XN); const float* x = F.in[0]; const f32x4* g4 = (const f32x4*)F.in[1] + F.lane;
    for (int m = gw; m < M; m += NGW) {
        const f32x4* xr = (const f32x4*)(x + (size_t)m * D) + F.lane; f32x4 v[4]; float s = 0.f;
#pragma unroll
        for (int j = 0; j < 4; ++j) { v[j] = xr[64 * j]; s += (v[j].x * v[j].x + v[j].y * v[j].y) + (v[j].z * v[j].z + v[j].w * v[j].w); }
        const float rstd = 1.0f / sqrtf(wave_sum(s) * (1.0f / D) + EPS);
        v2u* o8 = (v2u*)(XN + (size_t)m * D) + F.lane;
#pragma unroll
        for (int j = 0; j < 4; ++j) { const f32x4 g = g4[64 * j]; v2u o; o.x = pk2(v[j].x * rstd * g.x, v[j].y * rstd * g.y); o.y = pk2(v[j].z * rstd * g.z, v[j].w * rstd * g.w); o8[64 * j] = o; }
    }
}

template <bool PASS2> __device__ __forceinline__ void lru_phase(const Frame& F) {
    const int w = F.wave, lane = F.lane, fr = lane & 15, fq = lane >> 4;
    LAS float* aL = (LAS float*)F.lds; LAS float* bL = aL + TC * 512;
    const bf16* XL = (const bf16*)(F.ws + WS_XL); const bf16* GG = (const bf16*)(F.ws + WS_GG); bf16* Y = (bf16*)(F.ws + WS_Y);
    f32x2* AGG = (f32x2*)(F.ws + WS_AGG);
    const float* w4 = F.in[3]; const float* b4 = F.in[4]; const float* Wa = F.in[5] + (size_t)w * 4096; const float* ba = F.in[6]; const float* Wx = F.in[7] + (size_t)w * 4096; const float* bx = F.in[8];
    const float* lam = F.in[9]; const float* gl = F.in[14];
    bf16x8 fa[4][2], fx[4][2];
#pragma unroll
    for (int n = 0; n < 4; ++n)
#pragma unroll
        for (int kk = 0; kk < 2; ++kk) { const int co = 32 * (n >> 1) + 8 * ((fr >> 2) & 3) + 4 * (n & 1) + (fr & 3); const int ki = 32 * kk + 8 * fq;
            v4u ua, ux;
            ua.x = pk2(Wa[(ki + 0) * 64 + co], Wa[(ki + 1) * 64 + co]); ua.y = pk2(Wa[(ki + 2) * 64 + co], Wa[(ki + 3) * 64 + co]); ua.z = pk2(Wa[(ki + 4) * 64 + co], Wa[(ki + 5) * 64 + co]); ua.w = pk2(Wa[(ki + 6) * 64 + co], Wa[(ki + 7) * 64 + co]);
            ux.x = pk2(Wx[(ki + 0) * 64 + co], Wx[(ki + 1) * 64 + co]); ux.y = pk2(Wx[(ki + 2) * 64 + co], Wx[(ki + 3) * 64 + co]); ux.z = pk2(Wx[(ki + 4) * 64 + co], Wx[(ki + 5) * 64 + co]); ux.w = pk2(Wx[(ki + 6) * 64 + co], Wx[(ki + 7) * 64 + co]);
            fa[n][kk] = __builtin_bit_cast(bf16x8, ua); fx[n][kk] = __builtin_bit_cast(bf16x8, ux); }
    for (int ti = 0; ti * F.G < NTILE; ++ti) {
        const int tile = (ti & 1) ? ti * F.G + (F.G - 1 - F.bx) : ti * F.G + F.bx; if (tile >= NTILE) continue;
        const int b = tile / NCH, chunk = tile % NCH, t0 = chunk * TC; const size_t rowbase = (size_t)b * SEQ + t0;
#pragma unroll 1
        for (int m = 0; m < 2; ++m) {
            const int tt = 16 * m + fr, p = t0 + tt;
            float c[2][8];
#pragma unroll
            for (int kk = 0; kk < 2; ++kk) { const int ch = 64 * w + 32 * kk + 8 * fq;
                { const f32x4 b0 = *(const f32x4*)(b4 + ch), b1 = *(const f32x4*)(b4 + ch + 4);
#pragma unroll
                  for (int j = 0; j < 4; ++j) { c[kk][j] = b0[j]; c[kk][4 + j] = b1[j]; } }
#pragma unroll
                for (int k = 0; k < 4; ++k) { const int pp = p - 3 + k;
                    if (pp >= 0) { const v4u xv = *(const v4u*)(XL + ((size_t)b * SEQ + pp) * 512 + ch); const f32x4 w0 = *(const f32x4*)(w4 + k * 512 + ch), w1 = *(const f32x4*)(w4 + k * 512 + ch + 4);
                        c[kk][0] += w0[0] * bflo(xv.x); c[kk][1] += w0[1] * bfhi(xv.x); c[kk][2] += w0[2] * bflo(xv.y); c[kk][3] += w0[3] * bfhi(xv.y);
                        c[kk][4] += w1[0] * bflo(xv.z); c[kk][5] += w1[1] * bfhi(xv.z); c[kk][6] += w1[2] * bflo(xv.w); c[kk][7] += w1[3] * bfhi(xv.w); } } }
            bf16x8 cf[2];
#pragma unroll
            for (int kk = 0; kk < 2; ++kk) { v4u u; u.x = pk2(c[kk][0], c[kk][1]); u.y = pk2(c[kk][2], c[kk][3]); u.z = pk2(c[kk][4], c[kk][5]); u.w = pk2(c[kk][6], c[kk][7]); cf[kk] = __builtin_bit_cast(bf16x8, u); }
#pragma unroll
            for (int n = 0; n < 4; ++n) {
                f32x4 ar = (f32x4){0.f, 0.f, 0.f, 0.f}, ai = ar;
#pragma unroll
                for (int kk = 0; kk < 2; ++kk) { ar = __builtin_amdgcn_mfma_f32_16x16x32_bf16(fa[n][kk], cf[kk], ar, 0, 0, 0); ai = __builtin_amdgcn_mfma_f32_16x16x32_bf16(fx[n][kk], cf[kk], ai, 0, 0, 0); }
                const int kq = n >> 1, jb = 4 * (n & 1), gch = 64 * w + 32 * kq + 8 * fq + jb;
                const f32x4 vba = *(const f32x4*)(ba + gch), vbx = *(const f32x4*)(bx + gch), vl = *(const f32x4*)(lam + gch);
                f32x4 av, bv;
#pragma unroll
                for (int v = 0; v < 4; ++v) {
                    const float r = sigm(ar[v] + vba[v]), ig = sigm(ai[v] + vbx[v]);
                    const float z = -vl[v], sp = fmaxf(z, 0.f) + log1pf(__expf(-fabsf(z)));
                    const float la = -8.0f * r * sp; av[v] = expf(la); bv[v] = sqrtf(-expm1f(2.0f * la)) * (ig * c[kq][jb + v]); }
                const int cidx = 8 * kq + 2 * fq + (n & 1), o = tt * 512 + 64 * w + 4 * (cidx ^ fr);
                *(LAS f32x4*)(aL + o) = av; *(LAS f32x4*)(bL + o) = bv;
            }
        }
        asm volatile("s_waitcnt lgkmcnt(0)" ::: "memory");
        float h = 0.f, A = 1.f; const int gch = 64 * w + lane;
        if (PASS2) {
            const f32x2* ag = AGG + ((size_t)b * NCH) * 512 + gch;
#pragma unroll 16
            for (int j = 0; j < chunk; ++j) { const f32x2 q = ag[(size_t)j * 512]; h = q.x * h + q.y; }
        }
#pragma unroll 8
        for (int tok = 0; tok < TC; ++tok) { const int o = tok * 512 + 64 * w + 4 * ((lane >> 2) ^ (tok & 15)) + (lane & 3);
            const float a = aL[o], bb = bL[o]; h = a * h + bb; if (PASS2) bL[o] = h; else A *= a; }
        if (!PASS2) { AGG[((size_t)b * NCH + chunk) * 512 + gch] = (f32x2){A, h}; }
        else {
            __syncthreads();
            const f32x4 g0 = *(const f32x4*)(gl + 8 * lane), g1 = *(const f32x4*)(gl + 8 * lane + 4);
#pragma unroll
            for (int q = 0; q < 4; ++q) { const int tok = 4 * w + q; const size_t row = rowbase + tok;
                const int hb = tok * 512 + 64 * (lane >> 3), c0 = 2 * (lane & 7);
                const f32x4 h0 = *(const LAS f32x4*)(bL + hb + 4 * (c0 ^ (tok & 15))), h1 = *(const LAS f32x4*)(bL + hb + 4 * ((c0 + 1) ^ (tok & 15)));
                const v4u gg = *(const v4u*)(GG + row * 512 + 8 * lane);
                f32x4 y0, y1; y0[0] = h0[0] * bflo(gg.x); y0[1] = h0[1] * bfhi(gg.x); y0[2] = h0[2] * bflo(gg.y); y0[3] = h0[3] * bfhi(gg.y);
                y1[0] = h1[0] * bflo(gg.z); y1[1] = h1[1] * bfhi(gg.z); y1[2] = h1[2] * bflo(gg.w); y1[3] = h1[3] * bfhi(gg.w);
                float ss = (y0[0] * y0[0] + y0[1] * y0[1]) + (y0[2] * y0[2] + y0[3] * y0[3]) + (y1[0] * y1[0] + y1[1] * y1[1]) + (y1[2] * y1[2] + y1[3] * y1[3]);
                const float rstd = 1.0f / sqrtf(wave_sum(ss) * (1.0f / DL) + EPS);
                v4u o; o.x = pk2(y0[0] * rstd * g0[0], y0[1] * rstd * g0[1]); o.y = pk2(y0[2] * rstd * g0[2], y0[3] * rstd * g0[3]); o.z = pk2(y1[0] * rstd * g1[0], y1[1] * rstd * g1[1]); o.w = pk2(y1[2] * rstd * g1[2], y1[3] * rstd * g1[3]);
                *(v4u*)(Y + row * 1024 + 8 * lane) = o; }
            __syncthreads();
        }
    }
}

__device__ __forceinline__ void cm_tile(const Frame& F, int tile) {
    const int b = tile / NCH, chunk = tile % NCH, t0 = chunk * TC; const size_t rowbase = (size_t)b * SEQ + t0;
    LAS unsigned short* gin = (LAS unsigned short*)F.lds;
    LAS float* dL = (LAS float*)(F.lds + 62 * 1024);
    const bf16* GLU = (const bf16*)(F.ws + WS_GLU); bf16* Y = (bf16*)(F.ws + WS_Y);
    const int w = F.wave, lane = F.lane, tid = F.tid;
    for (int rr = w; rr < 62; rr += NWAVES) { const int p = t0 - 30 + rr; v4u v = (v4u){0u, 0u, 0u, 0u};
        if (p >= 0) v = *(const v4u*)(GLU + ((size_t)b * SEQ + p) * 512 + 8 * lane);
        *(LAS v4u*)(gin + rr * 512 + 8 * lane) = v; }
    float wt[31];
#pragma unroll
    for (int k = 0; k < 31; ++k) wt[k] = F.in[10][k * 512 + tid];
    const float bias = F.in[11][tid];
    __syncthreads();
#pragma unroll 1
    for (int g = 0; g < 4; ++g) {
        float acc[8];
#pragma unroll
        for (int j = 0; j < 8; ++j) acc[j] = bias;
#pragma unroll
        for (int k = 0; k < 38; ++k) { const float v = __uint_as_float((unsigned)gin[(8 * g + k) * 512 + tid] << 16);
#pragma unroll
            for (int j = 0; j < 8; ++j) { const int kk = k - j; if (kk >= 0 && kk < 31) acc[j] += wt[kk] * v; } }
#pragma unroll
        for (int j = 0; j < 8; ++j) dL[(8 * g + j) * 512 + tid] = acc[j];
    }
    __syncthreads();
    const float* lg = F.in[12]; const float* lb = F.in[13]; const float* gc = F.in[15];
    const f32x4 lg0 = *(const f32x4*)(lg + 8 * lane), lg1 = *(const f32x4*)(lg + 8 * lane + 4), lb0 = *(const f32x4*)(lb + 8 * lane), lb1 = *(const f32x4*)(lb + 8 * lane + 4);
    const f32x4 gc0 = *(const f32x4*)(gc + 8 * lane), gc1 = *(const f32x4*)(gc + 8 * lane + 4);
#pragma unroll
    for (int q = 0; q < 4; ++q) { const int tok = 4 * w + q; const size_t row = rowbase + tok;
        f32x4 d0 = *(const LAS f32x4*)(dL + tok * 512 + 8 * lane), d1 = *(const LAS f32x4*)(dL + tok * 512 + 8 * lane + 4);
        const float mean = wave_sum((d0[0] + d0[1]) + (d0[2] + d0[3]) + (d1[0] + d1[1]) + (d1[2] + d1[3])) * (1.0f / DC);
        d0 = d0 - mean; d1 = d1 - mean;
        const float var = wave_sum((d0[0] * d0[0] + d0[1] * d0[1]) + (d0[2] * d0[2] + d0[3] * d0[3]) + (d1[0] * d1[0] + d1[1] * d1[1]) + (d1[2] * d1[2] + d1[3] * d1[3])) * (1.0f / DC);
        const float rs = 1.0f / sqrtf(var + EPS);
        f32x4 s0 = d0 * rs * lg0 + lb0, s1 = d1 * rs * lg1 + lb1; float ss = 0.f;
#pragma unroll
        for (int e = 0; e < 4; ++e) { s0[e] = s0[e] * sigm(s0[e]); s1[e] = s1[e] * sigm(s1[e]); ss += s0[e] * s0[e] + s1[e] * s1[e]; }
        const float r2 = 1.0f / sqrtf(wave_sum(ss) * (1.0f / DC) + EPS);
        s0 = s0 * r2 * gc0; s1 = s1 * r2 * gc1;
        v4u o; o.x = pk2(s0[0], s0[1]); o.y = pk2(s0[2], s0[3]); o.z = pk2(s1[0], s1[1]); o.w = pk2(s1[2], s1[3]);
        *(v4u*)(Y + row * 1024 + 512 + 8 * lane) = o; }
    __syncthreads();
}

__device__ __forceinline__ void final_norm(const Frame& F) {
    const int gw = F.bx * NWAVES + F.wave, NGW = F.G * NWAVES; const float* S2 = (const float*)(F.ws + WS_S2);
    const f32x4* g4 = (const f32x4*)F.in[21] + F.lane;
    for (int m = gw; m < M; m += NGW) {
        f32x4* xr = (f32x4*)(F.out + (size_t)m * D) + F.lane; f32x4 v[4];
#pragma unroll
        for (int j = 0; j < 4; ++j) v[j] = xr[64 * j];
        const f32x4* sp = (const f32x4*)(S2 + (size_t)m * 16); const f32x4 s0 = sp[0], s1 = sp[1], s2 = sp[2], s3 = sp[3];
        const float tot = ((s0[0] + s0[1]) + (s0[2] + s0[3])) + ((s1[0] + s1[1]) + (s1[2] + s1[3])) + ((s2[0] + s2[1]) + (s2[2] + s2[3])) + ((s3[0] + s3[1]) + (s3[2] + s3[3]));
        const float rstd = 1.0f / sqrtf(tot * (1.0f / D) + EPS);
#pragma unroll
        for (int j = 0; j < 4; ++j) xr[64 * j] = v[j] * rstd * g4[64 * j];
    }
}

__global__ void __launch_bounds__(NWAVES * 64, 2) hymba_fwd(Args args) {
    extern __shared__ __attribute__((aligned(16))) unsigned char lds[];
    cg::grid_group grid = cg::this_grid();
    Frame F;
    F.lds = (LAS unsigned char*)lds; F.tid = threadIdx.x; F.lane = F.tid & 63; F.wave = __builtin_amdgcn_readfirstlane(F.tid >> 6); F.G = gridDim.x; F.bx = blockIdx.x;
#pragma unroll
    for (int i = 0; i < 22; ++i) F.in[i] = args.in[i];
    F.out = args.out; F.ws = args.ws;
    const int lo = args.ph_lo, hi = args.ph_hi;
#define IN(k) (lo <= (k) && (k) < hi)
#define SEAM(k) do { if (IN(k) && IN((k) + 1)) grid.sync(); } while (0)
    bf16* XN = (bf16*)(F.ws + WS_XN);
    if (IN(0)) { p0_prologue(F); } SEAM(0);
    if (IN(1)) { pg8::Gemm g{XN, (const bf16*)(F.ws + WS_WIN), M, DIN, D}; pg8::StaticOrder S; S.init(M, DIN, F.G, F.bx);
        pg8::EpiInProj E{(bf16*)(F.ws + WS_XL), (bf16*)(F.ws + WS_GG), (bf16*)(F.ws + WS_GLU)};
        pg8::gemm_phase<pg8::EpiInProj, pg8::StaticOrder, true, true>(F.lds, g, S, E); } SEAM(1);
    if (IN(2)) { lru_phase<false>(F); __syncthreads(); for (int t = F.bx; t < NTILE; t += F.G) cm_tile(F, t); } SEAM(2);
    if (IN(3)) { lru_phase<true>(F); } SEAM(3);
    if (IN(4)) { pg8::Gemm g{(const bf16*)(F.ws + WS_Y), (const bf16*)(F.ws + WS_WOUT), M, D, D}; pg8::StaticOrder S; S.init(M, D, F.G, F.bx);
        pg8::EpiResid<true> E{F.in[0], F.out, XN, F.in[17], (float*)(F.ws + WS_S1)};
        pg8::gemm_phase<pg8::EpiResid<true>, pg8::StaticOrder, true, true>(F.lds, g, S, E); } SEAM(4);
    if (IN(5)) { pg8::Gemm g{XN, (const bf16*)(F.ws + WS_WGU), M, NGU, D}; pg8::StaticOrder S; S.init(M, NGU, F.G, F.bx);
        pg8::EpiSwiGLU E{(bf16*)(F.ws + WS_H), (const float*)(F.ws + WS_S1), FF};
        pg8::gemm_phase<pg8::EpiSwiGLU, pg8::StaticOrder, true, true>(F.lds, g, S, E); } SEAM(5);
    if (IN(6)) { pg8::Gemm g{(const bf16*)(F.ws + WS_H), (const bf16*)(F.ws + WS_WD), M, D, FF}; pg8::StaticOrder S; S.init(M, D, F.G, F.bx);
        pg8::EpiResid<false> E{F.out, F.out, nullptr, nullptr, (float*)(F.ws + WS_S2)};
        pg8::gemm_phase<pg8::EpiResid<false>, pg8::StaticOrder, true, true>(F.lds, g, S, E); } SEAM(6);
    if (IN(7)) { final_norm(F); }
#undef IN
#undef SEAM
}

extern "C" void kernel_launch(void* const* d_in, const int* in_sizes, int n_in, void* d_out, int out_size, void* d_ws, size_t ws_size, hipStream_t stream) {
    static int grid = 0;
    if (grid == 0) {
        if (n_in != 22 || in_sizes[0] != M * D || out_size != M * D || ws_size < WS_END) { fprintf(stderr, "kernel_launch: unexpected shapes (n_in %d, ws %zu)\n", n_in, ws_size); grid = -1; return; }
        int dev = 0, cus = 0, per_cu = 0;
        if (hipGetDevice(&dev) != hipSuccess || hipDeviceGetAttribute(&cus, hipDeviceAttributeMultiprocessorCount, dev) != hipSuccess) { grid = -1; return; }
        if (hipFuncSetAttribute((const void*)hymba_fwd, hipFuncAttributeMaxDynamicSharedMemorySize, LDS_BYTES) != hipSuccess) { fprintf(stderr, "kernel_launch: hipFuncSetAttribute failed\n"); grid = -1; return; }
        if (hipOccupancyMaxActiveBlocksPerMultiprocessor(&per_cu, (const void*)hymba_fwd, NWAVES * 64, LDS_BYTES) != hipSuccess || per_cu < 1) { fprintf(stderr, "kernel_launch: occupancy query says %d blocks per CU\n", per_cu); (void)hipGetLastError(); grid = -1; return; }
        grid = cus;
    }
    if (grid < 0) return;
    Args a{};
    for (int i = 0; i < 22; ++i) a.in[i] = (const float*)d_in[i];
    a.out = (float*)d_out; a.ws = (unsigned char*)d_ws;
#if MK_N_LAUNCHES == 1
    a.ph_lo = 0; a.ph_hi = NPHASE;
    void* kargs[] = {&a};
    hipError_t e = hipLaunchCooperativeKernel((const void*)hymba_fwd, dim3(grid), dim3(NWAVES * 64), kargs, LDS_BYTES, stream);
    if (e != hipSuccess) fprintf(stderr, "kernel_launch: cooperative launch failed: %s (grid %d)\n", hipGetErrorString(e), grid);
#else
    for (int li = 0; li < NPHASE; ++li) { a.ph_lo = li; a.ph_hi = li + 1; hipLaunchKernelGGL(hymba_fwd, dim3(grid), dim3(NWAVES * 64), LDS_BYTES, stream, a); }
#endif
}
```

```cpp
#include <hip/hip_runtime.h>
#include <hip/hip_cooperative_groups.h>
#include <cstdio>
#include <cstdint>
namespace cg = cooperative_groups;
namespace pg8 {
#define PG8_LAS __attribute__((address_space(3)))
typedef unsigned short bf16_t;
typedef short bf16x8 __attribute__((ext_vector_type(8)));
typedef float f32x4 __attribute__((ext_vector_type(4)));
typedef unsigned u32x4 __attribute__((ext_vector_type(4)));
constexpr int BM = 256, BK = 64, HALF = 128, HTB = HALF * BK * 2  , STAGE_BYTES = 8 * HTB, NXCD = 8, WGM = 8;

__host__ __device__ __forceinline__ int lds_byte(int r, int c) { const int st = (r >> 4) * 2 + (c >> 5), rr = r & 15, cc = c & 31, ob = rr * 64 + cc * 2; return st * 1024 + (ob ^ (((ob >> 9) & 1) << 5)); }
__host__ __device__ __forceinline__ void stage_rc(int b, int& R, int& C) { const int st = b / 1024, sb = b % 1024, swz = sb ^ (((sb >> 9) & 1) << 5); R = (st >> 1) * 16 + swz / 64; C = (st & 1) * 32 + (swz % 64) / 2; }
__host__ __device__ __forceinline__ int perm32(int rho) { const int n = rho >> 4, i = rho & 15; return 8 * (i >> 2) + 4 * n + (i & 3); }

struct Unit { int pm, pn; };
struct Gemm { const bf16_t* A; const bf16_t* Bt; int M, N, K; };

struct StaticOrder {
    int nM, nN, nwg, G, c;
    __host__ __device__ void init(int M, int N, int G_, int c_) { nM = M / BM; nN = N / BM; nwg = nM * nN; G = G_; c = c_; }
    __host__ __device__ bool next(int i, Unit& u) const {
        const long L = (long)i * G + c; if (L >= nwg) return false;
        int wgid = (int)L; { const int q = nwg / NXCD, r = nwg % NXCD, xcd = wgid % NXCD, off = wgid / NXCD; wgid = (xcd < r ? xcd * (q + 1) : r * (q + 1) + (xcd - r) * q) + off; }
        const int nig = WGM * nN, gid = wgid / nig, fm = gid * WGM, gsz = (nM - fm) < WGM ? (nM - fm) : WGM;
        u.pm = fm + ((wgid % nig) % gsz); u.pn = (wgid % nig) / gsz; return true;
    }
    __device__ __forceinline__ void a_ready(const Unit&) const {}
    __device__ __forceinline__ void done(const Unit&) const {}
};

__device__ __forceinline__ unsigned cvt_pk_bf16(float lo, float hi) { unsigned r; asm volatile("v_cvt_pk_bf16_f32 %0, %1, %2" : "=v"(r) : "v"(lo), "v"(hi)); return r; }
typedef float f32x2 __attribute__((ext_vector_type(2)));
__device__ __forceinline__ float sigmoid_f(float x) { return __builtin_amdgcn_rcpf(1.0f + __expf(-x)); }
__device__ __forceinline__ float gelu_tanh_f(float x) { return x * sigmoid_f(1.5957691216057308f * (x + 0.044715f * x * x * x)); }
__device__ __forceinline__ u32x4 pack8(const f32x4 a, const f32x4 b) { u32x4 w; w.x = cvt_pk_bf16(a[0], a[1]); w.y = cvt_pk_bf16(a[2], a[3]); w.z = cvt_pk_bf16(b[0], b[1]); w.w = cvt_pk_bf16(b[2], b[3]); return w; }

struct EpiInProj {
    static constexpr bool PERM = true, AFTER_DRAIN = false;
    bf16_t *XL, *GG, *GLU;
    __device__ __forceinline__ void operator()(const f32x4 (&acc)[2][2][4][2], const Unit& u, int wr, int wc, int fr, int fq) const {
        const int row0 = u.pm * BM + wr * 64 + fr, cin = wc * 32 + 8 * fq;
        if (u.pn < 4) {
            bf16_t* base = (u.pn < 2 ? XL : GG) + (u.pn & 1) * 256 + cin; const bool act = u.pn >= 2;
#pragma unroll
            for (int ai = 0; ai < 2; ++ai)
#pragma unroll
                for (int m = 0; m < 4; ++m) { bf16_t* rowp = base + (size_t)(row0 + ai * HALF + m * 16) * 512;
#pragma unroll
                    for (int bj = 0; bj < 2; ++bj) { f32x4 v0 = acc[ai][bj][m][0], v1 = acc[ai][bj][m][1];
                        if (act) {
#pragma unroll
                            for (int e = 0; e < 4; ++e) { v0[e] = gelu_tanh_f(v0[e]); v1[e] = gelu_tanh_f(v1[e]); } }
                        *(u32x4*)(rowp + bj * HALF) = pack8(v0, v1); } }
        } else {
            bf16_t* base = GLU + (u.pn - 4) * 128 + cin;
#pragma unroll
            for (int ai = 0; ai < 2; ++ai)
#pragma unroll
                for (int m = 0; m < 4; ++m) { bf16_t* rowp = base + (size_t)(row0 + ai * HALF + m * 16) * 512; f32x4 v0, v1;
#pragma unroll
                    for (int e = 0; e < 4; ++e) { v0[e] = acc[ai][0][m][0][e] * sigmoid_f(acc[ai][1][m][0][e]); v1[e] = acc[ai][0][m][1][e] * sigmoid_f(acc[ai][1][m][1][e]); }
                    *(u32x4*)rowp = pack8(v0, v1); }
        }
    }
};
template <bool WRITE_XN> struct EpiResid {
    static constexpr bool PERM = true, AFTER_DRAIN = false;
    const float* X; float* OUT; bf16_t* XN; const float* gain; float* slots;
    __device__ __forceinline__ void operator()(const f32x4 (&acc)[2][2][4][2], const Unit& u, int wr, int wc, int fr, int fq) const {
        const int col0 = u.pn * BM + wc * 32 + 8 * fq;
        f32x4 gv[2][2];
        if (WRITE_XN) {
#pragma unroll
            for (int bj = 0; bj < 2; ++bj)
#pragma unroll
                for (int n = 0; n < 2; ++n) gv[bj][n] = *(const f32x4*)(gain + col0 + bj * HALF + 4 * n); }
#pragma unroll
        for (int ai = 0; ai < 2; ++ai)
#pragma unroll
            for (int m = 0; m < 4; ++m) { const int row = u.pm * BM + ai * HALF + wr * 64 + m * 16 + fr; const size_t off = (size_t)row * 1024 + col0; float ss = 0.f;
#pragma unroll
                for (int bj = 0; bj < 2; ++bj) {
                    const f32x4 x0 = *(const f32x4*)(X + off + bj * HALF), x1 = *(const f32x4*)(X + off + bj * HALF + 4);
                    const f32x4 v0 = x0 + acc[ai][bj][m][0], v1 = x1 + acc[ai][bj][m][1];
                    *(f32x4*)(OUT + off + bj * HALF) = v0; *(f32x4*)(OUT + off + bj * HALF + 4) = v1;
                    ss += (v0[0] * v0[0] + v0[1] * v0[1]) + (v0[2] * v0[2] + v0[3] * v0[3]) + (v1[0] * v1[0] + v1[1] * v1[1]) + (v1[2] * v1[2] + v1[3] * v1[3]);
                    if (WRITE_XN) *(u32x4*)(XN + off + bj * HALF) = pack8(v0 * gv[bj][0], v1 * gv[bj][1]); }
                ss += __shfl_xor(ss, 16); ss += __shfl_xor(ss, 32);
                if (fq == 0) slots[(size_t)row * 16 + u.pn * 4 + wc] = ss; }
    }
};
struct EpiSwiGLU {
    static constexpr bool PERM = true, AFTER_DRAIN = false;
    bf16_t* H; const float* slots; int ldh;
    __device__ __forceinline__ void operator()(const f32x4 (&acc)[2][2][4][2], const Unit& u, int wr, int wc, int fr, int fq) const {
        const int cin = u.pn * 128 + wc * 32 + 8 * fq;
#pragma unroll
        for (int ai = 0; ai < 2; ++ai)
#pragma unroll
            for (int m = 0; m < 4; ++m) { const int row = u.pm * BM + ai * HALF + wr * 64 + m * 16 + fr;
                const f32x4* sp = (const f32x4*)(slots + (size_t)row * 16); const f32x4 s0 = sp[0], s1 = sp[1], s2 = sp[2], s3 = sp[3];
                const float tot = ((s0[0] + s0[1]) + (s0[2] + s0[3])) + ((s1[0] + s1[1]) + (s1[2] + s1[3])) + ((s2[0] + s2[1]) + (s2[2] + s2[3])) + ((s3[0] + s3[1]) + (s3[2] + s3[3]));
                const float rstd = __builtin_amdgcn_rsqf(tot * (1.0f / 1024.0f) + 1e-6f);
                f32x4 v0, v1;
#pragma unroll
                for (int e = 0; e < 4; ++e) { const float g0 = acc[ai][0][m][0][e] * rstd, u0 = acc[ai][1][m][0][e] * rstd, g1 = acc[ai][0][m][1][e] * rstd, u1 = acc[ai][1][m][1][e] * rstd;
                    v0[e] = g0 * sigmoid_f(g0) * u0; v1[e] = g1 * sigmoid_f(g1) * u1; }
                *(u32x4*)(H + (size_t)row * ldh + cin) = pack8(v0, v1); }
    }
};

template <class Epi, class Sched, bool ALIGN_EPI = false, bool SP2 = false>
__device__ __forceinline__ void gemm_phase(PG8_LAS unsigned char* lds, const Gemm g, const Sched& S, const Epi& E) {
    const int tid = threadIdx.x, wid = __builtin_amdgcn_readfirstlane(tid >> 6), lane = tid & 63, wr = wid >> 2, wc = wid & 3, fr = lane & 15, fq = lane >> 4;
    const int K = g.K, nt = K / BK;
    unsigned voffA[2], voffB[2];
#pragma unroll
    for (int i = 0; i < 2; ++i) { int R, C; stage_rc(tid * 16 + i * 8192, R, C); const int Rb = Epi::PERM ? ((R & ~31) + perm32(R & 31)) : R;
        voffA[i] = (unsigned)(R * K + C) * 2u; voffB[i] = (unsigned)(Rb * K + C) * 2u; }
    const size_t kstep = (size_t)(BK * 2);
    const size_t hstep = (size_t)HALF * K * 2;
    const size_t tstep = 2 * hstep;
    const unsigned ldsw = (unsigned)wid * 1024u;
    const int aoff = lds_byte(wr * 64 + fr, fq * 8), boff = lds_byte(wc * 32 + fr, fq * 8);
#define PG8_SA(b, h) (((b) * 2 + (h)) * HTB)
#define PG8_SB(b, h) ((4 + (b) * 2 + (h)) * HTB)
#define PG8_STAGE(bufoff, gbase, voff) do { _Pragma("unroll") for (int _i = 0; _i < 2; ++_i) \
        __builtin_amdgcn_global_load_lds((const unsigned*)((const char*)(gbase) + (voff)[_i]), (PG8_LAS unsigned*)(lds + (bufoff) + ldsw + _i * 8192), 16, 0, 0); } while (0)
#define PG8_LDA(dst, b, h) do { _Pragma("unroll") for (int m = 0; m < 4; ++m) _Pragma("unroll") for (int k = 0; k < 2; ++k) dst[m][k] = *(const PG8_LAS bf16x8*)(lds + PG8_SA(b, h) + aoff + m * 2048 + k * 1024); } while (0)
#define PG8_LDB(dst, b, h) do { _Pragma("unroll") for (int n = 0; n < 2; ++n) _Pragma("unroll") for (int k = 0; k < 2; ++k) dst[n][k] = *(const PG8_LAS bf16x8*)(lds + PG8_SB(b, h) + boff + n * 2048 + k * 1024); } while (0)
#define PG8_MMA(ai, bj, At, Bt) do { __builtin_amdgcn_s_setprio(1); _Pragma("unroll") for (int m = 0; m < 4; ++m) _Pragma("unroll") for (int n = 0; n < 2; ++n) _Pragma("unroll") for (int k = 0; k < 2; ++k) \
        acc[ai][bj][m][n] = __builtin_amdgcn_mfma_f32_16x16x32_bf16(Bt[n][k], At[m][k], acc[ai][bj][m][n], 0, 0, 0); __builtin_amdgcn_s_setprio(0); } while (0)
#define PG8_WAIT_V(n) asm volatile("s_waitcnt vmcnt(" #n ")" ::: "memory")
#define PG8_WAIT_L(n) asm volatile("s_waitcnt lgkmcnt(" #n ")" ::: "memory")
#define PG8_BAR __builtin_amdgcn_s_barrier()
#define PG8_SCHED __builtin_amdgcn_sched_barrier(0)
    Unit cur, nxt; int ui = 0;
    if (!S.next(0, cur)) return;
    f32x4 acc[2][2][4][2];
#pragma unroll
    for (int a = 0; a < 2; ++a)
#pragma unroll
        for (int b = 0; b < 2; ++b)
#pragma unroll
            for (int m = 0; m < 4; ++m)
#pragma unroll
                for (int n = 0; n < 2; ++n) acc[a][b][m][n] = (f32x4){0.f, 0.f, 0.f, 0.f};
    bf16x8 At[4][2], B0[2][2], B1[2][2];
    const char* cA = (const char*)g.A + (size_t)cur.pm * tstep; const char* cB = (const char*)g.Bt + (size_t)cur.pn * tstep;
    S.a_ready(cur);
    if constexpr (SP2) {
        PG8_STAGE(PG8_SB(0, 0), cB, voffB); PG8_STAGE(PG8_SB(0, 1), cB + hstep, voffB); PG8_STAGE(PG8_SA(0, 0), cA, voffA); PG8_STAGE(PG8_SA(0, 1), cA + hstep, voffA);
        if (wr == 1) PG8_BAR;
        PG8_WAIT_V(2); PG8_BAR;
        PG8_STAGE(PG8_SB(1, 0), cB + kstep, voffB); PG8_STAGE(PG8_SA(1, 0), cA + kstep, voffA); PG8_STAGE(PG8_SB(1, 1), cB + hstep + kstep, voffB);
        PG8_WAIT_V(6); PG8_BAR;
    } else {
        PG8_STAGE(PG8_SB(0, 0), cB, voffB); PG8_STAGE(PG8_SA(0, 0), cA, voffA); PG8_STAGE(PG8_SB(0, 1), cB + hstep, voffB); PG8_STAGE(PG8_SA(0, 1), cA + hstep, voffA);
        if (wr == 1) PG8_BAR;
        PG8_WAIT_V(4); PG8_BAR;
        PG8_STAGE(PG8_SB(1, 0), cB + kstep, voffB); PG8_STAGE(PG8_SA(1, 0), cA + kstep, voffA); PG8_STAGE(PG8_SB(1, 1), cB + hstep + kstep, voffB);
        PG8_WAIT_V(6); PG8_BAR;
    }
    for (;;) {
        const bool has_next = S.next(ui + 1, nxt);
        const char* nA = has_next ? (const char*)g.A + (size_t)nxt.pm * tstep : cA; const char* nB = has_next ? (const char*)g.Bt + (size_t)nxt.pn * tstep : cB;
        for (int t = 0; t < nt; t += 2) {
            const bool last = (t == nt - 2);
            const char* a1 = cA + (size_t)(t + 1) * kstep;
            const char* a2 = last ? nA : cA + (size_t)(t + 2) * kstep; const char* b2 = last ? nB : cB + (size_t)(t + 2) * kstep;
            const char* a3 = a2 + kstep; const char* b3 = b2 + kstep;
            if (last && has_next) S.a_ready(nxt);
            if constexpr (SP2) {
            PG8_LDB(B0, 0, 0); PG8_LDB(B1, 0, 1); PG8_SCHED; PG8_LDA(At, 0, 0); PG8_STAGE(PG8_SA(1, 1), a1 + hstep, voffA);
            PG8_WAIT_V(8); PG8_WAIT_L(0); PG8_BAR; PG8_MMA(0, 0, At, B0); PG8_MMA(0, 1, At, B1); PG8_BAR; PG8_SCHED;
            PG8_LDA(At, 0, 1); PG8_STAGE(PG8_SB(0, 0), b2, voffB); PG8_STAGE(PG8_SB(0, 1), b2 + hstep, voffB); PG8_STAGE(PG8_SA(0, 0), a2, voffA);
            PG8_WAIT_V(8); PG8_WAIT_L(0); PG8_BAR; PG8_MMA(1, 0, At, B0); PG8_MMA(1, 1, At, B1); PG8_BAR; PG8_SCHED;
            PG8_LDB(B0, 1, 0); PG8_LDB(B1, 1, 1); PG8_SCHED; PG8_LDA(At, 1, 0); PG8_STAGE(PG8_SA(0, 1), a2 + hstep, voffA);
            PG8_WAIT_V(8); PG8_WAIT_L(0); PG8_BAR; PG8_MMA(0, 0, At, B0); PG8_MMA(0, 1, At, B1); PG8_BAR; PG8_SCHED;
            PG8_LDA(At, 1, 1); PG8_STAGE(PG8_SB(1, 0), b3, voffB); PG8_STAGE(PG8_SB(1, 1), b3 + hstep, voffB); PG8_STAGE(PG8_SA(1, 0), a3, voffA);
            PG8_WAIT_V(8); PG8_WAIT_L(0); PG8_BAR; PG8_MMA(1, 0, At, B0); PG8_MMA(1, 1, At, B1); PG8_BAR; PG8_SCHED;
            } else {
            PG8_LDB(B0, 0, 0); PG8_SCHED; PG8_LDA(At, 0, 0); PG8_STAGE(PG8_SA(1, 1), a1 + hstep, voffA);
            PG8_WAIT_L(8); PG8_BAR; PG8_WAIT_L(0); PG8_MMA(0, 0, At, B0); PG8_BAR; PG8_SCHED;
            PG8_LDB(B1, 0, 1); PG8_STAGE(PG8_SB(0, 0), b2, voffB);
            PG8_BAR; PG8_WAIT_L(0); PG8_MMA(0, 1, At, B1); PG8_BAR;
            PG8_LDA(At, 0, 1); PG8_STAGE(PG8_SA(0, 0), a2, voffA);
            PG8_BAR; PG8_WAIT_L(0); PG8_MMA(1, 0, At, B0); PG8_BAR; PG8_SCHED;
            PG8_STAGE(PG8_SB(0, 1), b2 + hstep, voffB);
            PG8_WAIT_V(6); PG8_BAR; PG8_MMA(1, 1, At, B1); PG8_BAR;
            PG8_LDB(B0, 1, 0); PG8_SCHED; PG8_LDA(At, 1, 0); PG8_STAGE(PG8_SA(0, 1), a2 + hstep, voffA);
            PG8_WAIT_L(8); PG8_BAR; PG8_WAIT_L(0); PG8_MMA(0, 0, At, B0); PG8_BAR; PG8_SCHED;
            PG8_LDB(B1, 1, 1); PG8_STAGE(PG8_SB(1, 0), b3, voffB);
            PG8_BAR; PG8_WAIT_L(0); PG8_MMA(0, 1, At, B1); PG8_BAR;
            PG8_LDA(At, 1, 1); PG8_STAGE(PG8_SA(1, 0), a3, voffA);
            PG8_BAR; PG8_WAIT_L(0); PG8_MMA(1, 0, At, B0); PG8_BAR; PG8_SCHED;
            PG8_STAGE(PG8_SB(1, 1), b3 + hstep, voffB);
            PG8_WAIT_V(6); PG8_BAR; PG8_MMA(1, 1, At, B1); PG8_BAR;
            }
        }
        if constexpr (ALIGN_EPI) { if (wr == 0) PG8_BAR; }
        if constexpr (!Epi::AFTER_DRAIN) { E(acc, cur, wr, wc, fr, fq); S.done(cur); }
        if (!has_next) break;
#pragma unroll
        for (int a = 0; a < 2; ++a)
#pragma unroll
            for (int b = 0; b < 2; ++b)
#pragma unroll
                for (int m = 0; m < 4; ++m)
#pragma unroll
                    for (int n = 0; n < 2; ++n) acc[a][b][m][n] = (f32x4){0.f, 0.f, 0.f, 0.f};
        cur = nxt; cA = nA; cB = nB; ++ui;
        if constexpr (ALIGN_EPI) { if (wr == 1) PG8_BAR; }
    }
    PG8_WAIT_V(0);
    if constexpr (!ALIGN_EPI) { if (wr == 0) PG8_BAR; }
    PG8_BAR;
    if constexpr (Epi::AFTER_DRAIN) { E.fused(acc, cur, wr, wc, fr, fq, lds, wid, lane); S.done(cur); }
#undef PG8_SA
#undef PG8_SB
#undef PG8_STAGE
#undef PG8_LDA
#undef PG8_LDB
#undef PG8_MMA
#undef PG8_WAIT_V
#undef PG8_WAIT_L
#undef PG8_BAR
#undef PG8_SCHED
}
}

#ifndef MK_N_LAUNCHES
#define MK_N_LAUNCHES 1
#endif
constexpr int NWAVES = 8, NPHASE = 8;
constexpr int BATCH = 4, SEQ = 4096, D = 1024, DL = 512, DC = 512, DIN = 2048, FF = 2816, NGU = 2 * FF;
constexpr int M = BATCH * SEQ;
constexpr float EPS = 1e-6f;
constexpr int TC = 32, NCH = SEQ / TC, NTILE = M / TC;

constexpr size_t MiB = 1u << 20;
constexpr size_t WS_CTL = 0, CTL_ZERO_BYTES = 65536;
constexpr size_t WS_WIN = 2 * MiB, WS_WOUT = 6 * MiB, WS_WGU = 8 * MiB, WS_WD = 19 * MiB;
constexpr size_t WS_S1 = 25 * MiB, WS_S2 = 26 * MiB, WS_AGG = 27 * MiB, WS_WF = 29 * MiB;
constexpr size_t WS_XN = 32 * MiB;
constexpr size_t WS_XL = 64 * MiB, WS_GG = 80 * MiB, WS_GLU = 96 * MiB, WS_Y = 112 * MiB;
constexpr size_t WS_H = 64 * MiB, WS_END = 152 * MiB;
static_assert(WS_WD + (size_t)D * FF * 2 <= WS_S1 && WS_AGG + (size_t)BATCH * NCH * 512 * 8 <= WS_XN && WS_H + (size_t)M * FF * 2 <= WS_END, "d_ws map");

constexpr int RING_BYTES = 131072, LDS_BYTES = 147456;

#define GAS __attribute__((address_space(1)))
#define LAS __attribute__((address_space(3)))
typedef unsigned short bf16;
typedef unsigned v4u __attribute__((ext_vector_type(4)));
typedef unsigned v2u __attribute__((ext_vector_type(2)));
typedef float f32x4 __attribute__((ext_vector_type(4)));
typedef float f32x2 __attribute__((ext_vector_type(2)));
typedef short bf16x8 __attribute__((ext_vector_type(8)));
__device__ __forceinline__ unsigned f2bf(float f) { unsigned u = __builtin_bit_cast(unsigned, f); return (u + 0x7fffu + ((u >> 16) & 1u)) >> 16; }
__device__ __forceinline__ unsigned pk2(float lo, float hi) { return f2bf(lo) | (f2bf(hi) << 16); }
__device__ __forceinline__ float bflo(unsigned w) { return __uint_as_float(w << 16); }
__device__ __forceinline__ float bfhi(unsigned w) { return __uint_as_float(w & 0xffff0000u); }
__device__ __forceinline__ float sigm(float x) { return __builtin_amdgcn_rcpf(1.0f + __expf(-x)); }
__device__ __forceinline__ float wave_sum(float v) {
#pragma unroll
    for (int o = 1; o < 64; o <<= 1) v += __shfl_xor(v, o);
    return v;
}

#define RLX_AGENT __ATOMIC_RELAXED, __HIP_MEMORY_SCOPE_AGENT
#define XB_TMO      128
#define XB_XCNT(j)  (256  + 64 * (j))
#define XB_XSUB(j)  (1280 + 64 * (j))
#define XB_XGEN(j)  (2304 + 64 * (j))
#define XB_TOP      3328
#define XB_TOPGEN   3392
#define XCD_BAR_WORDS 3456
#define XB_SPIN_CAP (1u << 18)

__device__ __forceinline__ unsigned xb_ld(unsigned* p)              { return __hip_atomic_load(p, __ATOMIC_RELAXED, __HIP_MEMORY_SCOPE_AGENT); }
__device__ __forceinline__ unsigned xb_add(unsigned* p, unsigned v) { return __hip_atomic_fetch_add(p, v, __ATOMIC_RELAXED, __HIP_MEMORY_SCOPE_AGENT); }
__device__ __forceinline__ unsigned xb_xcc_id() { return (unsigned)__builtin_amdgcn_s_getreg((3 << 11) | 20) & 0xFu; }
#define XB_SPIN(cond, bar) do { unsigned _sp = 0; while (cond) { __builtin_amdgcn_s_sleep(1); \
    if ((++_sp & 255u) == 0u) { if (xb_ld(&(bar)[XB_TMO])) break; if (_sp > XB_SPIN_CAP) { atomicAdd(&(bar)[XB_TMO], 1u); break; } } } } while (0)

struct XcdBarrier {
    unsigned* bar; unsigned x;
    volatile LAS unsigned* st;
};

__device__ __forceinline__ XcdBarrier xcd_barrier_post(unsigned* bar, volatile LAS unsigned* st) {
    XcdBarrier b; b.bar = bar; b.x = xb_xcc_id(); b.st = st;
    if (threadIdx.x == 0) (void)xb_add(&bar[XB_XCNT(b.x)], 1u);
    return b;
}
__device__ __forceinline__ void xcd_barrier_complete(unsigned* bar, unsigned x, unsigned& nloc, unsigned& nx) {
    const unsigned G = gridDim.x * gridDim.y * gridDim.z;
    unsigned sum, cnt, mine, sp = 0u;
    for (;;) {
        sum = 0u; cnt = 0u; mine = 0u;
#pragma unroll
        for (unsigned j = 0; j < 16; ++j) { const unsigned c = xb_ld(&bar[XB_XCNT(j)]); sum += c; cnt += (c > 0u) ? 1u : 0u; mine = (j == x) ? c : mine; }
        if (sum == G) break;
        __builtin_amdgcn_s_sleep(1);
        if ((++sp & 255u) == 0u) { if (xb_ld(&bar[XB_TMO])) break; if (sp > XB_SPIN_CAP) { atomicAdd(&bar[XB_TMO], 1u); break; } }
    }
    nloc = mine > 0u ? mine : 1u; nx = cnt > 0u ? cnt : 1u;
}

__device__ __forceinline__ void xcd_barrier(const XcdBarrier& b) {
    asm volatile("s_waitcnt vmcnt(0)" ::: "memory");
    __syncthreads();
    if (threadIdx.x == 0) {
        unsigned* bar = b.bar;
        __builtin_amdgcn_s_waitcnt(0);
        unsigned nloc = b.st[0], nx = b.st[1];
        if (nloc == 0u) { xcd_barrier_complete(bar, b.x, nloc, nx); b.st[0] = nloc; b.st[1] = nx; }
        const unsigned old = xb_add(&bar[XB_XSUB(b.x)], 1u);
        const unsigned gen = old / nloc;
        if (old + 1u == (gen + 1u) * nloc) {
            __builtin_amdgcn_fence(__ATOMIC_RELEASE, "agent");
            asm volatile("s_waitcnt vmcnt(0)" ::: "memory");
            const unsigned og = xb_add(&bar[XB_TOP], 1u);
            const unsigned tg = og / nx;
            if (og + 1u == (tg + 1u) * nx) xb_add(&bar[XB_TOPGEN], 1u);
            else XB_SPIN(xb_ld(&bar[XB_TOPGEN]) == tg, bar);
            __builtin_amdgcn_fence(__ATOMIC_ACQUIRE, "agent");
            xb_add(&bar[XB_XGEN(b.x)], 1u);
            asm volatile("s_waitcnt vmcnt(0)" ::: "memory");
        } else {
            XB_SPIN(xb_ld(&bar[XB_XGEN(b.x)]) == gen, bar);
            __builtin_amdgcn_fence(__ATOMIC_ACQUIRE, "agent");
            asm volatile("s_waitcnt vmcnt(0)" ::: "memory");
        }
    }
    __syncthreads();
}

struct Frame {
    LAS unsigned char* lds; int tid, lane, wave, G, bx;
    const float* in[22]; float* out; unsigned char* ws;
};
struct Args { const float* in[22]; float* out; unsigned char* ws; int ph_lo, ph_hi; };

__device__ __forceinline__ void transpose_item(const float* W, int K, int N, bf16* WT, int k0, int n0, int drow0, LAS float* scr, int lane) {
#pragma unroll 8
    for (int i = 0; i < 32; ++i) { const int kk = 2 * i + (lane >> 5); scr[kk * 33 + (lane & 31)] = W[(size_t)(k0 + kk) * N + n0 + (lane & 31)]; }
    asm volatile("s_waitcnt lgkmcnt(0)" ::: "memory");
    const int c = lane & 7;
#pragma unroll
    for (int j = 0; j < 4; ++j) { const int n = (lane >> 3) + 8 * j; const LAS float* s = scr + (8 * c) * 33 + n;
        v4u o; o.x = pk2(s[0 * 33], s[1 * 33]); o.y = pk2(s[2 * 33], s[3 * 33]); o.z = pk2(s[4 * 33], s[5 * 33]); o.w = pk2(s[6 * 33], s[7 * 33]);
        *(v4u*)(WT + (size_t)(drow0 + n) * K + k0 + 8 * c) = o; }
    asm volatile("s_waitcnt lgkmcnt(0)" ::: "memory");
}
__device__ __forceinline__ int il128(int n, int half) { return 256 * (n >> 7) + 128 * half + (n & 127); }
__device__ __forceinline__ void p0_prologue(const Frame& F) {
    LAS float* scr = (LAS float*)(F.lds + F.wave * 16384);
    const int gw = F.bx * NWAVES + F.wave, NGW = F.G * NWAVES;
    constexpr int I_IN = (D / 64) * (DIN / 32), I_OUT = (D / 64) * (D / 32), I_G = (D / 64) * (FF / 32), I_D = (FF / 64) * (D / 32);
    constexpr int NITEMS = I_IN + I_OUT + 2 * I_G + I_D;
    bf16* Win_t = (bf16*)(F.ws + WS_WIN); bf16* Wout_t = (bf16*)(F.ws + WS_WOUT); bf16* Wgu_t = (bf16*)(F.ws + WS_WGU); bf16* Wd_t = (bf16*)(F.ws + WS_WD);
    for (int it = gw; it < NITEMS; it += NGW) {
        int r = it;
        if (r < I_IN) { const int nb = DIN / 32, k0 = 64 * (r / nb), n0 = 32 * (r % nb);
            const int dr = n0 < 1024 ? n0 : (n0 < 1536 ? 1024 + il128(n0 - 1024, 0) : 1024 + il128(n0 - 1536, 1));
            transpose_item(F.in[2], D, DIN, Win_t, k0, n0, dr, scr, F.lane); continue; } r -= I_IN;
        if (r < I_OUT) { const int nb = D / 32, k0 = 64 * (r / nb), n0 = 32 * (r % nb); transpose_item(F.in[16], D, D, Wout_t, k0, n0, n0, scr, F.lane); continue; } r -= I_OUT;
        if (r < I_G) { const int nb = FF / 32, k0 = 64 * (r / nb), n0 = 32 * (r % nb); transpose_item(F.in[18], D, FF, Wgu_t, k0, n0, il128(n0, 0), scr, F.lane); continue; } r -= I_G;
        if (r < I_G) { const int nb = FF / 32, k0 = 64 * (r / nb), n0 = 32 * (r % nb); transpose_item(F.in[19], D, FF, Wgu_t, k0, n0, il128(n0, 1), scr, F.lane); continue; } r -= I_G;
        { const int nb = D / 32, k0 = 64 * (r / nb), n0 = 32 * (r % nb); transpose_item(F.in[20], FF, D, Wd_t, k0, n0, n0, scr, F.lane); }
    }
    if (gw < 16) {
        const float* Wg = F.in[(gw & 1) ? 7 : 5] + (size_t)(gw >> 1) * 4096; const int fr = F.lane & 15, fq = F.lane >> 4;
#pragma unroll
        for (int n = 0; n < 4; ++n)
#pragma unroll
            for (int kk = 0; kk < 2; ++kk) { const int co = 32 * (n >> 1) + 8 * ((fr >> 2) & 3) + 4 * (n & 1) + (fr & 3), ki = 32 * kk + 8 * fq;
                v4u u; u.x = pk2(Wg[(ki + 0) * 64 + co], Wg[(ki + 1) * 64 + co]); u.y = pk2(Wg[(ki + 2) * 64 + co], Wg[(ki + 3) * 64 + co]); u.z = pk2(Wg[(ki + 4) * 64 + co], Wg[(ki + 5) * 64 + co]); u.w = pk2(Wg[(ki + 6) * 64 + co], Wg[(ki + 7) * 64 + co]);
                *((v4u*)(F.ws + WS_WF) + (size_t)(gw * 8 + n * 2 + kk) * 64 + F.lane) = u; }
    }
    bf16* XN = (bf16*)(F.ws + WS_XN); const float* x = F.in[0]; const f32x4* g4 = (const f32x4*)F.in[1] + F.lane;
    for (int m = gw; m < M; m += NGW) {
        const f32x4* xr = (const f32x4*)(x + (size_t)m * D) + F.lane; f32x4 v[4]; float s = 0.f;
#pragma unroll
        for (int j = 0; j < 4; ++j) { v[j] = xr[64 * j]; s += (v[j].x * v[j].x + v[j].y * v[j].y) + (v[j].z * v[j].z + v[j].w * v[j].w); }
        const float rstd = 1.0f / sqrtf(wave_sum(s) * (1.0f / D) + EPS);
        v2u* o8 = (v2u*)(XN + (size_t)m * D) + F.lane;
#pragma unroll
        for (int j = 0; j < 4; ++j) { const f32x4 g = g4[64 * j]; v2u o; o.x = pk2(v[j].x * rstd * g.x, v[j].y * rstd * g.y); o.y = pk2(v[j].z * rstd * g.z, v[j].w * rstd * g.w); o8[64 * j] = o; }
    }
}

__device__ __forceinline__ unsigned cvtpk(float lo, float hi) { return pg8::cvt_pk_bf16(lo, hi); }
template <bool PASS2> __device__ __forceinline__ void lru_phase(const Frame& F) {
    const int w = F.wave, lane = F.lane, fr = lane & 15, fq = lane >> 4, tid = F.tid;
    LAS float* aL = (LAS float*)F.lds; LAS float* bL = aL + TC * 512; LAS float* cst = (LAS float*)(F.lds + RING_BYTES);
    const bf16* XL = (const bf16*)(F.ws + WS_XL); const bf16* GG = (const bf16*)(F.ws + WS_GG); bf16* Y = (bf16*)(F.ws + WS_Y);
    f32x2* AGG = (f32x2*)(F.ws + WS_AGG);
    { const float z = -F.in[9][tid];
      cst[0 * 512 + tid] = F.in[3][0 * 512 + tid]; cst[1 * 512 + tid] = F.in[3][1 * 512 + tid]; cst[2 * 512 + tid] = F.in[3][2 * 512 + tid]; cst[3 * 512 + tid] = F.in[3][3 * 512 + tid];
      cst[4 * 512 + tid] = F.in[4][tid]; cst[5 * 512 + tid] = F.in[6][tid]; cst[6 * 512 + tid] = F.in[8][tid]; cst[7 * 512 + tid] = -8.0f * (fmaxf(z, 0.f) + log1pf(expf(-fabsf(z)))); }
    bf16x8 fa[4][2], fx[4][2];
    { const bf16x8* wf = (const bf16x8*)(F.ws + WS_WF) + (size_t)(w * 2) * 8 * 64 + lane;
#pragma unroll
      for (int n = 0; n < 4; ++n)
#pragma unroll
          for (int kk = 0; kk < 2; ++kk) { fa[n][kk] = wf[(n * 2 + kk) * 64]; fx[n][kk] = wf[(8 + n * 2 + kk) * 64]; } }
    const f32x4 g0 = *(const f32x4*)(F.in[14] + 8 * lane), g1 = *(const f32x4*)(F.in[14] + 8 * lane + 4);
    __syncthreads();
    for (int ti = 0; ti * F.G < NTILE; ++ti) {
        const int tile = (ti & 1) ? ti * F.G + (F.G - 1 - F.bx) : ti * F.G + F.bx; if (tile >= NTILE) continue;
        const int b = tile / NCH, chunk = tile % NCH, t0 = chunk * TC; const size_t rowbase = (size_t)b * SEQ + t0;
        const int gch = 64 * w + lane;
        float h = 0.f, A = 1.f;
        if (PASS2) {
            const f32x2* ag = AGG + ((size_t)b * NCH) * 512;
            for (int j0 = 0; j0 < chunk; j0 += 16) { f32x2 q[16];
#pragma unroll
                for (int j = 0; j < 16; ++j) { const int jj = j0 + j; const f32x2* rowp = ag + (size_t)(jj < chunk ? jj : 0) * 512; q[j] = rowp[gch]; }
#pragma unroll
                for (int j = 0; j < 16; ++j) { if (j0 + j < chunk) h = q[j].x * h + q[j].y; } }
        }
#pragma unroll 1
        for (int m = 0; m < 2; ++m) {
            const int tt = 16 * m + fr, p = t0 + tt;
            v4u xv[2][4];
#pragma unroll
            for (int kk = 0; kk < 2; ++kk)
#pragma unroll
                for (int k = 0; k < 4; ++k) { const int pp = p - 3 + k; xv[kk][k] = *(const v4u*)(XL + ((size_t)b * SEQ + (pp < 0 ? 0 : pp)) * 512 + 64 * w + 32 * kk + 8 * fq); }
            float c[2][8];
#pragma unroll
            for (int kk = 0; kk < 2; ++kk) { const int ch = 64 * w + 32 * kk + 8 * fq;
                { const f32x4 b0 = *(const LAS f32x4*)(cst + 4 * 512 + ch), b1 = *(const LAS f32x4*)(cst + 4 * 512 + ch + 4);
#pragma unroll
                  for (int j = 0; j < 4; ++j) { c[kk][j] = b0[j]; c[kk][4 + j] = b1[j]; } }
#pragma unroll
                for (int k = 0; k < 4; ++k) { const float msk = (p - 3 + k) >= 0 ? 1.0f : 0.0f; const v4u xq = xv[kk][k];
                    const f32x4 w0 = *(const LAS f32x4*)(cst + k * 512 + ch) * msk, w1 = *(const LAS f32x4*)(cst + k * 512 + ch + 4) * msk;
                    c[kk][0] += w0[0] * bflo(xq.x); c[kk][1] += w0[1] * bfhi(xq.x); c[kk][2] += w0[2] * bflo(xq.y); c[kk][3] += w0[3] * bfhi(xq.y);
                    c[kk][4] += w1[0] * bflo(xq.z); c[kk][5] += w1[1] * bfhi(xq.z); c[kk][6] += w1[2] * bflo(xq.w); c[kk][7] += w1[3] * bfhi(xq.w); } }
            bf16x8 cf[2];
#pragma unroll
            for (int kk = 0; kk < 2; ++kk) { v4u u; u.x = cvtpk(c[kk][0], c[kk][1]); u.y = cvtpk(c[kk][2], c[kk][3]); u.z = cvtpk(c[kk][4], c[kk][5]); u.w = cvtpk(c[kk][6], c[kk][7]); cf[kk] = __builtin_bit_cast(bf16x8, u); }
#pragma unroll
            for (int n = 0; n < 4; ++n) {
                __builtin_amdgcn_sched_barrier(0);
                f32x4 ar = (f32x4){0.f, 0.f, 0.f, 0.f}, ai = ar;
#pragma unroll
                for (int kk = 0; kk < 2; ++kk) { ar = __builtin_amdgcn_mfma_f32_16x16x32_bf16(fa[n][kk], cf[kk], ar, 0, 0, 0); ai = __builtin_amdgcn_mfma_f32_16x16x32_bf16(fx[n][kk], cf[kk], ai, 0, 0, 0); }
                const int kq = n >> 1, jb = 4 * (n & 1), lch = 64 * w + 32 * kq + 8 * fq + jb;
                const f32x4 vba = *(const LAS f32x4*)(cst + 5 * 512 + lch), vbx = *(const LAS f32x4*)(cst + 6 * 512 + lch), vc8 = *(const LAS f32x4*)(cst + 7 * 512 + lch);
                f32x4 av, bv;
#pragma unroll
                for (int v = 0; v < 4; ++v) {
                    const float r = sigm(ar[v] + vba[v]), ig = sigm(ai[v] + vbx[v]);
                    const float la = r * vc8[v], a = __expf(la), y = 2.0f * la;
                    const float poly = -y * (1.0f + y * (0.5f + y * (0.16666667f + y * (0.041666668f + y * (0.0083333338f + y * (0.0013888889f + y * 0.0001984127f))))));
                    const float om = y < -0.25f ? 1.0f - a * a : poly;
                    av[v] = a; bv[v] = __builtin_amdgcn_sqrtf(om) * (ig * c[kq][jb + v]); }
                const int cidx = 8 * kq + 2 * fq + (n & 1), o = tt * 512 + 64 * w + 4 * (cidx ^ fr);
                *(LAS f32x4*)(aL + o) = av; *(LAS f32x4*)(bL + o) = bv;
            }
        }
        asm volatile("s_waitcnt lgkmcnt(0)" ::: "memory");
#pragma unroll 16
        for (int tok = 0; tok < TC; ++tok) { const int o = tok * 512 + 64 * w + 4 * ((lane >> 2) ^ (tok & 15)) + (lane & 3);
            const float a = aL[o], bb = bL[o]; h = a * h + bb; if (PASS2) bL[o] = h; else A *= a; }
        if (!PASS2) { AGG[((size_t)b * NCH + chunk) * 512 + gch] = (f32x2){A, h}; }
        else {
            v4u gg[4];
#pragma unroll
            for (int q = 0; q < 4; ++q) gg[q] = *(const v4u*)(GG + (rowbase + 4 * w + q) * 512 + 8 * lane);
            __syncthreads();
#pragma unroll
            for (int q = 0; q < 4; ++q) { const int tok = 4 * w + q; const size_t row = rowbase + tok;
                const int hb = tok * 512 + 64 * (lane >> 3), c0 = 2 * (lane & 7);
                const f32x4 h0 = *(const LAS f32x4*)(bL + hb + 4 * (c0 ^ (tok & 15))), h1 = *(const LAS f32x4*)(bL + hb + 4 * ((c0 + 1) ^ (tok & 15)));
                f32x4 y0, y1; y0[0] = h0[0] * bflo(gg[q].x); y0[1] = h0[1] * bfhi(gg[q].x); y0[2] = h0[2] * bflo(gg[q].y); y0[3] = h0[3] * bfhi(gg[q].y);
                y1[0] = h1[0] * bflo(gg[q].z); y1[1] = h1[1] * bfhi(gg[q].z); y1[2] = h1[2] * bflo(gg[q].w); y1[3] = h1[3] * bfhi(gg[q].w);
                float ss = (y0[0] * y0[0] + y0[1] * y0[1]) + (y0[2] * y0[2] + y0[3] * y0[3]) + (y1[0] * y1[0] + y1[1] * y1[1]) + (y1[2] * y1[2] + y1[3] * y1[3]);
                const float rstd = 1.0f / sqrtf(wave_sum(ss) * (1.0f / DL) + EPS);
                y0 = y0 * rstd * g0; y1 = y1 * rstd * g1;
                v4u o; o.x = cvtpk(y0[0], y0[1]); o.y = cvtpk(y0[2], y0[3]); o.z = cvtpk(y1[0], y1[1]); o.w = cvtpk(y1[2], y1[3]);
                *(v4u*)(Y + row * 1024 + 8 * lane) = o; }
            __syncthreads();
        }
    }
    __syncthreads();
}

__device__ __forceinline__ void cm_phase(const Frame& F) {
    LAS unsigned short* gin = (LAS unsigned short*)F.lds;
    LAS float* dL = (LAS float*)(F.lds + 62 * 1024);
    const bf16* GLU = (const bf16*)(F.ws + WS_GLU); bf16* Y = (bf16*)(F.ws + WS_Y);
    const int w = F.wave, lane = F.lane, tid = F.tid;
    float wt[31];
#pragma unroll
    for (int k = 0; k < 31; ++k) wt[k] = F.in[10][k * 512 + tid];
    const float bias = F.in[11][tid];
    const float* lg = F.in[12]; const float* lb = F.in[13]; const float* gc = F.in[15];
    const f32x4 lg0 = *(const f32x4*)(lg + 8 * lane), lg1 = *(const f32x4*)(lg + 8 * lane + 4), lb0 = *(const f32x4*)(lb + 8 * lane), lb1 = *(const f32x4*)(lb + 8 * lane + 4);
    const f32x4 gc0 = *(const f32x4*)(gc + 8 * lane), gc1 = *(const f32x4*)(gc + 8 * lane + 4);
    for (int tile = F.bx; tile < NTILE; tile += F.G) {
        const int b = tile / NCH, chunk = tile % NCH, t0 = chunk * TC; const size_t rowbase = (size_t)b * SEQ + t0;
        { v4u v[8];
#pragma unroll
          for (int i = 0; i < 8; ++i) { const int rr = w + 8 * i, p = t0 - 30 + rr; v[i] = (v4u){0u, 0u, 0u, 0u}; if (rr < 62 && p >= 0) v[i] = *(const v4u*)(GLU + ((size_t)b * SEQ + p) * 512 + 8 * lane); }
#pragma unroll
          for (int i = 0; i < 8; ++i) { const int rr = w + 8 * i; if (rr < 62) *(LAS v4u*)(gin + rr * 512 + 8 * lane) = v[i]; } }
        __syncthreads();
#pragma unroll 1
        for (int g = 0; g < 4; ++g) {
            float acc[8];
#pragma unroll
            for (int j = 0; j < 8; ++j) acc[j] = bias;
#pragma unroll
            for (int k = 0; k < 38; ++k) { const float v = __uint_as_float((unsigned)gin[(8 * g + k) * 512 + tid] << 16);
#pragma unroll
                for (int j = 0; j < 8; ++j) { const int kk = k - j; if (kk >= 0 && kk < 31) acc[j] += wt[kk] * v; } }
#pragma unroll
            for (int j = 0; j < 8; ++j) dL[(8 * g + j) * 512 + tid] = acc[j];
        }
        __syncthreads();
#pragma unroll
        for (int q = 0; q < 4; ++q) { const int tok = 4 * w + q; const size_t row = rowbase + tok;
            f32x4 d0 = *(const LAS f32x4*)(dL + tok * 512 + 8 * lane), d1 = *(const LAS f32x4*)(dL + tok * 512 + 8 * lane + 4);
            const float mean = wave_sum((d0[0] + d0[1]) + (d0[2] + d0[3]) + (d1[0] + d1[1]) + (d1[2] + d1[3])) * (1.0f / DC);
            d0 = d0 - mean; d1 = d1 - mean;
            const float var = wave_sum((d0[0] * d0[0] + d0[1] * d0[1]) + (d0[2] * d0[2] + d0[3] * d0[3]) + (d1[0] * d1[0] + d1[1] * d1[1]) + (d1[2] * d1[2] + d1[3] * d1[3])) * (1.0f / DC);
            const float rs = 1.0f / sqrtf(var + EPS);
            f32x4 s0 = d0 * rs * lg0 + lb0, s1 = d1 * rs * lg1 + lb1; float ss = 0.f;
#pragma unroll
            for (int e = 0; e < 4; ++e) { s0[e] = s0[e] * sigm(s0[e]); s1[e] = s1[e] * sigm(s1[e]); ss += s0[e] * s0[e] + s1[e] * s1[e]; }
            const float r2 = 1.0f / sqrtf(wave_sum(ss) * (1.0f / DC) + EPS);
            s0 = s0 * r2 * gc0; s1 = s1 * r2 * gc1;
            v4u o; o.x = cvtpk(s0[0], s0[1]); o.y = cvtpk(s0[2], s0[3]); o.z = cvtpk(s1[0], s1[1]); o.w = cvtpk(s1[2], s1[3]);
            *(v4u*)(Y + row * 1024 + 512 + 8 * lane) = o; }
        __syncthreads();
    }
}

__device__ __forceinline__ void final_norm(const Frame& F) {
    const int gw = F.bx * NWAVES + F.wave, NGW = F.G * NWAVES; const float* S2 = (const float*)(F.ws + WS_S2);
    const f32x4* g4 = (const f32x4*)F.in[21] + F.lane;
    for (int m = gw; m < M; m += NGW) {
        f32x4* xr = (f32x4*)(F.out + (size_t)m * D) + F.lane; f32x4 v[4];
#pragma unroll
        for (int j = 0; j < 4; ++j) v[j] = xr[64 * j];
        const f32x4* sp = (const f32x4*)(S2 + (size_t)m * 16); const f32x4 s0 = sp[0], s1 = sp[1], s2 = sp[2], s3 = sp[3];
        const float tot = ((s0[0] + s0[1]) + (s0[2] + s0[3])) + ((s1[0] + s1[1]) + (s1[2] + s1[3])) + ((s2[0] + s2[1]) + (s2[2] + s2[3])) + ((s3[0] + s3[1]) + (s3[2] + s3[3]));
        const float rstd = 1.0f / sqrtf(tot * (1.0f / D) + EPS);
#pragma unroll
        for (int j = 0; j < 4; ++j) xr[64 * j] = v[j] * rstd * g4[64 * j];
    }
}

__global__ void __launch_bounds__(NWAVES * 64, 2) hymba_fwd(Args args) {
    extern __shared__ __attribute__((aligned(16))) unsigned char lds[];
    __shared__ __attribute__((aligned(16))) unsigned xb_st[4];
    if (threadIdx.x < 4) xb_st[threadIdx.x] = 0u;
    __syncthreads();
    XcdBarrier bar = xcd_barrier_post((unsigned*)args.ws + 0, (volatile LAS unsigned*)xb_st);
    Frame F;
    F.lds = (LAS unsigned char*)lds; F.tid = threadIdx.x; F.lane = F.tid & 63; F.wave = __builtin_amdgcn_readfirstlane(F.tid >> 6); F.G = gridDim.x; F.bx = blockIdx.x;
#pragma unroll
    for (int i = 0; i < 22; ++i) F.in[i] = args.in[i];
    F.out = args.out; F.ws = args.ws;
    const int lo = args.ph_lo, hi = args.ph_hi;
#define IN(k) (lo <= (k) && (k) < hi)
#define SEAM(k) do { if (IN(k) && IN((k) + 1)) xcd_barrier(bar); } while (0)
    bf16* XN = (bf16*)(F.ws + WS_XN);
    if (IN(0)) { p0_prologue(F); } SEAM(0);
    if (IN(1)) { pg8::Gemm g{XN, (const bf16*)(F.ws + WS_WIN), M, DIN, D}; pg8::StaticOrder S; S.init(M, DIN, F.G, F.bx);
        pg8::EpiInProj E{(bf16*)(F.ws + WS_XL), (bf16*)(F.ws + WS_GG), (bf16*)(F.ws + WS_GLU)};
        pg8::gemm_phase<pg8::EpiInProj, pg8::StaticOrder, true, true>(F.lds, g, S, E); } SEAM(1);
    if (IN(2)) { lru_phase<false>(F); cm_phase(F); } SEAM(2);
    if (IN(3)) { lru_phase<true>(F); } SEAM(3);
    if (IN(4)) { pg8::Gemm g{(const bf16*)(F.ws + WS_Y), (const bf16*)(F.ws + WS_WOUT), M, D, D}; pg8::StaticOrder S; S.init(M, D, F.G, F.bx);
        pg8::EpiResid<true> E{F.in[0], F.out, XN, F.in[17], (float*)(F.ws + WS_S1)};
        pg8::gemm_phase<pg8::EpiResid<true>, pg8::StaticOrder, true, true>(F.lds, g, S, E); } SEAM(4);
    if (IN(5)) { pg8::Gemm g{XN, (const bf16*)(F.ws + WS_WGU), M, NGU, D}; pg8::StaticOrder S; S.init(M, NGU, F.G, F.bx);
        pg8::EpiSwiGLU E{(bf16*)(F.ws + WS_H), (const float*)(F.ws + WS_S1), FF};
        pg8::gemm_phase<pg8::EpiSwiGLU, pg8::StaticOrder, true, true>(F.lds, g, S, E); } SEAM(5);
    if (IN(6)) { pg8::Gemm g{(const bf16*)(F.ws + WS_H), (const bf16*)(F.ws + WS_WD), M, D, FF}; pg8::StaticOrder S; S.init(M, D, F.G, F.bx);
        pg8::EpiResid<false> E{F.out, F.out, nullptr, nullptr, (float*)(F.ws + WS_S2)};
        pg8::gemm_phase<pg8::EpiResid<false>, pg8::StaticOrder, true, true>(F.lds, g, S, E); } SEAM(6);
    if (IN(7)) { final_norm(F); }
#undef IN
#undef SEAM
}

extern "C" void kernel_launch(void* const* d_in, const int* in_sizes, int n_in, void* d_out, int out_size, void* d_ws, size_t ws_size, hipStream_t stream) {
    static int grid = 0;
    if (grid == 0) {
        if (n_in != 22 || in_sizes[0] != M * D || out_size != M * D || ws_size < WS_END) { fprintf(stderr, "kernel_launch: unexpected shapes (n_in %d, ws %zu)\n", n_in, ws_size); grid = -1; return; }
        int dev = 0, cus = 0, per_cu = 0;
        if (hipGetDevice(&dev) != hipSuccess || hipDeviceGetAttribute(&cus, hipDeviceAttributeMultiprocessorCount, dev) != hipSuccess) { grid = -1; return; }
        if (hipFuncSetAttribute((const void*)hymba_fwd, hipFuncAttributeMaxDynamicSharedMemorySize, LDS_BYTES) != hipSuccess) { fprintf(stderr, "kernel_launch: hipFuncSetAttribute failed\n"); grid = -1; return; }
        if (hipOccupancyMaxActiveBlocksPerMultiprocessor(&per_cu, (const void*)hymba_fwd, NWAVES * 64, LDS_BYTES) != hipSuccess || per_cu < 1) { fprintf(stderr, "kernel_launch: occupancy query says %d blocks per CU\n", per_cu); (void)hipGetLastError(); grid = -1; return; }
        grid = cus;
    }
    if (grid < 0) return;
    Args a{};
    for (int i = 0; i < 22; ++i) a.in[i] = (const float*)d_in[i];
    a.out = (float*)d_out; a.ws = (unsigned char*)d_ws;
    if (hipMemsetAsync((char*)d_ws + WS_CTL, 0, CTL_ZERO_BYTES, stream) != hipSuccess) { fprintf(stderr, "kernel_launch: memset failed\n"); return; }
#if MK_N_LAUNCHES == 1
    a.ph_lo = 0; a.ph_hi = NPHASE;
    void* kargs[] = {&a};
    hipError_t e = hipLaunchCooperativeKernel((const void*)hymba_fwd, dim3(grid), dim3(NWAVES * 64), kargs, LDS_BYTES, stream);
    if (e != hipSuccess) fprintf(stderr, "kernel_launch: cooperative launch failed: %s (grid %d)\n", hipGetErrorString(e), grid);
#else
    for (int li = 0; li < NPHASE; ++li) { a.ph_lo = li; a.ph_hi = li + 1; hipLaunchKernelGGL(hymba_fwd, dim3(grid), dim3(NWAVES * 64), LDS_BYTES, stream, a); }
#endif
}
```
